# Optimizing an MI355X kernel written in HIP

```python
import math
import jax, jax.numpy as jnp
from jax import lax
import numpy as np

D_MODEL = 2048
BATCH = 1
SEQ = 16384
DEPTH = 1

A_HEADS = 16
A_KV_HEADS = 4
A_HEAD_DIM = 64
A_GROUP = A_HEADS // A_KV_HEADS
WINDOW = 128
BAND_BLOCK = 128
B_HEADS = 16
B_Q_LORA = 512
B_KV_LORA = 256
B_NOPE = 64
B_ROPE = 32
B_V = 64
ROPE_THETA = 10000.0
Q_BLOCK = 128
D_FF = 4 * D_MODEL
EPS = 1e-6
NEG_INF = -1e30

A_Q_W = A_HEADS * A_HEAD_DIM
A_KV_W = A_KV_HEADS * A_HEAD_DIM
A_OUT_W = A_HEADS * A_HEAD_DIM
B_OUT_W = B_HEADS * B_V
IN_SPLITS = (A_Q_W, A_KV_W, A_KV_W, B_Q_LORA, B_KV_LORA, B_ROPE, D_MODEL, D_MODEL)
IN_WIDTH = int(sum(IN_SPLITS))
IN_OFFSETS = tuple(int(v) for v in np.cumsum(IN_SPLITS)[:-1])

kernel_name = "gated_swa_mla_hybrid_encoder"


def rms_norm(x, g):
    xf = x.astype(jnp.float32)
    y = xf * lax.rsqrt(jnp.mean(xf * xf, axis=-1, keepdims=True) + EPS)
    return (y * g.astype(jnp.float32)).astype(x.dtype)


def alibi_slopes(n_heads):
    return jnp.exp2(-8.0 * (jnp.arange(n_heads, dtype=jnp.float32) + 1.0) / n_heads)


def apply_rope(x, pos):
    half = x.shape[-1] // 2
    inv = ROPE_THETA ** (-jnp.arange(half, dtype=jnp.float32) / half)
    ang = pos.astype(jnp.float32)[..., None] * inv
    cos = jnp.cos(ang)[:, :, None, :]
    sin = jnp.sin(ang)[:, :, None, :]
    x1 = x[..., :half].astype(jnp.float32)
    x2 = x[..., half:].astype(jnp.float32)
    out = jnp.concatenate([x1 * cos - x2 * sin, x2 * cos + x1 * sin], axis=-1)
    return out.astype(x.dtype)


def band_blocks(t, n_blocks):
    b = t.shape[0]
    pad = [(0, 0), (BAND_BLOCK, BAND_BLOCK)] + [(0, 0)] * (t.ndim - 2)
    tb = jnp.pad(t, pad).reshape(b, n_blocks + 2, BAND_BLOCK, *t.shape[2:])
    return jnp.concatenate([tb[:, :-2], tb[:, 1:-1], tb[:, 2:]], axis=2)


def windowed_gqa_sink(q, k, v, pos, sink):
    b, s = q.shape[0], q.shape[1]
    nb = s // BAND_BLOCK
    qb = q.reshape(b, nb, BAND_BLOCK, A_KV_HEADS, A_GROUP, A_HEAD_DIM)
    kb = band_blocks(k, nb)
    vb = band_blocks(v, nb)
    r = jnp.arange(BAND_BLOCK, dtype=jnp.int32)[:, None]
    c = jnp.arange(3 * BAND_BLOCK, dtype=jnp.int32)[None, :]
    in_win = jnp.abs(BAND_BLOCK + r - c) <= WINDOW
    kglob = (jnp.arange(nb, dtype=jnp.int32)[:, None, None] - 1) * BAND_BLOCK + c[None]
    mask = in_win[None] & (kglob >= 0) & (kglob < s)
    pq = pos.reshape(b, nb, BAND_BLOCK)
    pk = band_blocks(pos, nb)
    dist = jnp.abs(pq[..., :, None] - pk[..., None, :]).astype(jnp.float32)
    slopes = alibi_slopes(A_HEADS).reshape(A_KV_HEADS, A_GROUP)
    scale = A_HEAD_DIM ** -0.5
    scores = jnp.einsum('bnqhgd,bnchd->bnhgqc', qb, kb).astype(jnp.float32) * scale
    scores = scores - slopes[None, None, :, :, None, None] * dist[:, :, None, None]
    scores = jnp.where(mask[None, :, None, None], scores, NEG_INF)
    sk = sink.astype(jnp.float32).reshape(A_KV_HEADS, A_GROUP)[None, None, :, :, None, None]
    m = jnp.maximum(jnp.max(scores, axis=-1, keepdims=True), sk)
    p = jnp.exp(scores - m)
    denom = jnp.sum(p, axis=-1, keepdims=True) + jnp.exp(sk - m)
    probs = (p / denom).astype(v.dtype)
    out = jnp.einsum('bnhgqc,bnchd->bnqhgd', probs, vb)
    return out.reshape(b, s, A_OUT_W)


def mla_attention(c_q, c_kv, k_r, pos, g_q, g_kv, w_uq, w_uk, w_uv):
    b, s = c_q.shape[0], c_q.shape[1]
    c_q = rms_norm(c_q, g_q)
    c_kv = rms_norm(c_kv, g_kv)
    q = jnp.einsum('bsc,chd->bshd', c_q, w_uq)
    q_nope = q[..., :B_NOPE]
    q_rope = apply_rope(q[..., B_NOPE:], pos)
    k_nope = jnp.einsum('bsc,chd->bshd', c_kv, w_uk)
    val = jnp.einsum('bsc,chd->bshd', c_kv, w_uv)
    k_rope = apply_rope(k_r[:, :, None, :], pos)[:, :, 0]
    scale = (B_NOPE + B_ROPE) ** -0.5
    nb = s // Q_BLOCK
    qn = q_nope.reshape(b, nb, Q_BLOCK, B_HEADS, B_NOPE).transpose(1, 0, 2, 3, 4)
    qr = q_rope.reshape(b, nb, Q_BLOCK, B_HEADS, B_ROPE).transpose(1, 0, 2, 3, 4)

    def query_block(args):
        qn_b, qr_b = args
        sc = (jnp.einsum('bqhd,bkhd->bhqk', qn_b, k_nope)
              + jnp.einsum('bqhr,bkr->bhqk', qr_b, k_rope)).astype(jnp.float32) * scale
        p = jax.nn.softmax(sc, axis=-1).astype(val.dtype)
        return jnp.einsum('bhqk,bkhd->bqhd', p, val)

    o = lax.map(query_block, (qn, qr))
    return o.transpose(1, 0, 2, 3, 4).reshape(b, s, B_OUT_W)


def setup_inputs(seed: int = 0) -> dict:
    key = jax.random.key(seed)
    ks = jax.random.split(key, 20)

    def w(k, shape, fan_in):
        return jax.random.normal(k, shape, jnp.float32) * (fan_in ** -0.5)

    def gain(k, shape):
        return 1.0 + 0.02 * jax.random.normal(k, shape, jnp.float32)

    x = jax.random.normal(ks[0], (BATCH, SEQ, D_MODEL), jnp.float32)
    positions = jnp.broadcast_to(jnp.arange(SEQ, dtype=jnp.int32)[None, :], (BATCH, SEQ))
    return {
        "x": x,
        "positions": positions,
        "attn_norm_g": gain(ks[1], (DEPTH, D_MODEL)),
        "w_in": w(ks[2], (DEPTH, D_MODEL, IN_WIDTH), D_MODEL),
        "a_sink": 0.5 * jax.random.normal(ks[3], (DEPTH, A_HEADS), jnp.float32),
        "b_q_norm_g": gain(ks[4], (DEPTH, B_Q_LORA)),
        "b_kv_norm_g": gain(ks[5], (DEPTH, B_KV_LORA)),
        "b_w_uq": w(ks[6], (DEPTH, B_Q_LORA, B_HEADS, B_NOPE + B_ROPE), B_Q_LORA),
        "b_w_uk": w(ks[7], (DEPTH, B_KV_LORA, B_HEADS, B_NOPE), B_KV_LORA),
        "b_w_uv": w(ks[8], (DEPTH, B_KV_LORA, B_HEADS, B_V), B_KV_LORA),
        "w_branch_a": w(ks[9], (DEPTH, A_OUT_W, D_MODEL), A_OUT_W),
        "w_branch_b": w(ks[10], (DEPTH, B_OUT_W, D_MODEL), B_OUT_W),
        "w_out": w(ks[11], (DEPTH, D_MODEL, D_MODEL), D_MODEL),
        "mlp_norm_g": gain(ks[12], (DEPTH, D_MODEL)),
        "w_mlp_in": w(ks[13], (DEPTH, D_MODEL, D_FF), D_MODEL),
        "w_mlp_out": w(ks[14], (DEPTH, D_FF, D_MODEL), D_FF),
        "final_norm_g": gain(ks[15], (D_MODEL,)),
    }


def reference(x, positions, attn_norm_g, w_in, a_sink, b_q_norm_g, b_kv_norm_g,
              b_w_uq, b_w_uk, b_w_uv, w_branch_a, w_branch_b, w_out,
              mlp_norm_g, w_mlp_in, w_mlp_out, final_norm_g):
    b, s, _ = x.shape
    for l in range(DEPTH):
        h = rms_norm(x, attn_norm_g[l])
        proj = jnp.einsum('bsd,de->bse', h, w_in[l])
        qa, ka, va, c_q, c_kv, k_r, gate_a, gate_b = jnp.split(proj, IN_OFFSETS, axis=-1)
        o_a = windowed_gqa_sink(
            qa.reshape(b, s, A_HEADS, A_HEAD_DIM),
            ka.reshape(b, s, A_KV_HEADS, A_HEAD_DIM),
            va.reshape(b, s, A_KV_HEADS, A_HEAD_DIM),
            positions, a_sink[l])
        o_b = mla_attention(c_q, c_kv, k_r, positions, b_q_norm_g[l], b_kv_norm_g[l],
                            b_w_uq[l], b_w_uk[l], b_w_uv[l])
        merged = (jax.nn.sigmoid(gate_a) * jnp.einsum('bse,ed->bsd', o_a, w_branch_a[l])
                  + jax.nn.sigmoid(gate_b) * jnp.einsum('bse,ed->bsd', o_b, w_branch_b[l]))
        x = x + jnp.einsum('bsd,de->bse', merged, w_out[l])
        h2 = rms_norm(x, mlp_norm_g[l])
        u = jax.nn.relu(jnp.einsum('bsd,df->bsf', h2, w_mlp_in[l]))
        x = x + jnp.einsum('bsf,fd->bsd', u * u, w_mlp_out[l])
    return rms_norm(x, final_norm_g)
```

```cpp
#include <hip/hip_runtime.h>
#include <hip/hip_cooperative_groups.h>
#include <cstdio>
#include <cstdint>
namespace cg = cooperative_groups;
__device__ __forceinline__ int lane_now() { int l; asm volatile("v_mbcnt_lo_u32_b32 %0, -1, 0\n\tv_mbcnt_hi_u32_b32 %0, -1, %0" : "=v"(l)); return l; }
namespace pg8 {
#define PG8_LAS __attribute__((address_space(3)))
typedef unsigned short bf16_t;
typedef short bf16x8 __attribute__((ext_vector_type(8)));
typedef float f32x4 __attribute__((ext_vector_type(4)));
typedef unsigned u32x4 __attribute__((ext_vector_type(4)));
constexpr int BM = 256, BK = 64, HALF = 128, HTB = HALF * BK * 2  , STAGE_BYTES = 8 * HTB, NXCD = 8, WGM = 8;

__host__ __device__ __forceinline__ int lds_byte(int r, int c) { const int st = (r >> 4) * 2 + (c >> 5), rr = r & 15, cc = c & 31, ob = rr * 64 + cc * 2; return st * 1024 + (ob ^ (((ob >> 9) & 1) << 5)); }
__host__ __device__ __forceinline__ void stage_rc(int b, int& R, int& C) { const int st = b / 1024, sb = b % 1024, swz = sb ^ (((sb >> 9) & 1) << 5); R = (st >> 1) * 16 + swz / 64; C = (st & 1) * 32 + (swz % 64) / 2; }
__host__ __device__ __forceinline__ int perm32(int rho) { const int n = rho >> 4, i = rho & 15; return 8 * (i >> 2) + 4 * n + (i & 3); }

struct Unit { int pm, pn; };
struct Gemm { const bf16_t* A; const bf16_t* Bt; int M, N, K; };

struct StaticOrder {
    int nM, nN, nwg, G, c;
    __host__ __device__ void init(int M, int N, int G_, int c_) { nM = M / BM; nN = N / BM; nwg = nM * nN; G = G_; c = c_; }
    __host__ __device__ bool next(int i, Unit& u) const {
        const long L = (long)i * G + c; if (L >= nwg) return false;
        int wgid = (int)L; { const int q = nwg / NXCD, r = nwg % NXCD, xcd = wgid % NXCD, off = wgid / NXCD; wgid = (xcd < r ? xcd * (q + 1) : r * (q + 1) + (xcd - r) * q) + off; }
        const int nig = WGM * nN, gid = wgid / nig, fm = gid * WGM, gsz = (nM - fm) < WGM ? (nM - fm) : WGM;
        u.pm = fm + ((wgid % nig) % gsz); u.pn = (wgid % nig) / gsz; return true;
    }
    __device__ __forceinline__ void a_ready(const Unit&) const {}
    __device__ __forceinline__ void done(const Unit&) const {}
};

__device__ __forceinline__ unsigned cvt_pk_bf16(float lo, float hi) { unsigned r; asm volatile("v_cvt_pk_bf16_f32 %0, %1, %2" : "=v"(r) : "v"(lo), "v"(hi)); return r; }
typedef float f32x2 __attribute__((ext_vector_type(2)));
__device__ __forceinline__ u32x4 pack8(f32x4 a, f32x4 b) { u32x4 w; w.x = cvt_pk_bf16(a[0], a[1]); w.y = cvt_pk_bf16(a[2], a[3]); w.z = cvt_pk_bf16(b[0], b[1]); w.w = cvt_pk_bf16(b[2], b[3]); return w; }
__device__ __forceinline__ void st8(bf16_t* p, f32x4 a, f32x4 b) { *(u32x4*)p = pack8(a, b); }
__device__ __forceinline__ void ld8f(const bf16_t* p, f32x4& a, f32x4& b) {
    const u32x4 w = *(const u32x4*)p;
    a[0] = __uint_as_float(w.x << 16); a[1] = __uint_as_float(w.x & 0xffff0000u); a[2] = __uint_as_float(w.y << 16); a[3] = __uint_as_float(w.y & 0xffff0000u);
    b[0] = __uint_as_float(w.z << 16); b[1] = __uint_as_float(w.z & 0xffff0000u); b[2] = __uint_as_float(w.w << 16); b[3] = __uint_as_float(w.w & 0xffff0000u);
}
__device__ __forceinline__ void up8(const u32x4 w, f32x4& a, f32x4& b) {
    a[0] = __uint_as_float(w.x << 16); a[1] = __uint_as_float(w.x & 0xffff0000u); a[2] = __uint_as_float(w.y << 16); a[3] = __uint_as_float(w.y & 0xffff0000u);
    b[0] = __uint_as_float(w.z << 16); b[1] = __uint_as_float(w.z & 0xffff0000u); b[2] = __uint_as_float(w.w << 16); b[3] = __uint_as_float(w.w & 0xffff0000u);
}
struct NoPre {};
__device__ __forceinline__ float sq4(f32x4 v) { return (v[0] * v[0] + v[1] * v[1]) + (v[2] * v[2] + v[3] * v[3]); }
__device__ __forceinline__ float rowred(float s) { s += __shfl_xor(s, 16); s += __shfl_xor(s, 32); return s; }
__device__ __forceinline__ void rope8(f32x4& a0, f32x4& a1, const float* c, const float* s) {
    const f32x4 cv = *(const f32x4*)c, sv = *(const f32x4*)s; float x1, x2;
    x1 = a0[0]; x2 = a0[1]; a0[0] = x1 * cv[0] - x2 * sv[0]; a0[1] = x2 * cv[0] + x1 * sv[0];
    x1 = a0[2]; x2 = a0[3]; a0[2] = x1 * cv[1] - x2 * sv[1]; a0[3] = x2 * cv[1] + x1 * sv[1];
    x1 = a1[0]; x2 = a1[1]; a1[0] = x1 * cv[2] - x2 * sv[2]; a1[1] = x2 * cv[2] + x1 * sv[2];
    x1 = a1[2]; x2 = a1[3]; a1[2] = x1 * cv[3] - x2 * sv[3]; a1[3] = x2 * cv[3] + x1 * sv[3];
}
__device__ __forceinline__ f32x4 sigm4(f32x4 v) { f32x4 r;
#pragma unroll
    for (int i = 0; i < 4; ++i) r[i] = __builtin_amdgcn_rcpf(1.0f + __builtin_amdgcn_exp2f(-1.4426950408889634f * v[i]));
    return r; }
constexpr float RMS_EPS = 1e-6f;
__device__ __forceinline__ float frmax(float v) { v = fmaxf(v, __shfl_xor(v, 1)); v = fmaxf(v, __shfl_xor(v, 2)); v = fmaxf(v, __shfl_xor(v, 4)); v = fmaxf(v, __shfl_xor(v, 8)); return v; }
#define NOFIN __device__ __forceinline__ void finish(int, int, float, float) const {}

template <class F> struct EpiRow {
    static constexpr bool PERM = true, AFTER_DRAIN = false;
    F f;
    __device__ __forceinline__ void operator()(const f32x4 (&acc)[2][2][4][2], const Unit& u, int wr, int wc, int fr, int fq) const {
        const int lc = wc * 32 + 8 * fq; float s0 = 0.f, s1 = 0.f;
#pragma unroll
        for (int ai = 0; ai < 2; ++ai) {
            typename F::Pre pre[4];
#pragma unroll
            for (int m = 0; m < 4; ++m) pre[m] = f.pre(u.pm * BM + ai * HALF + wr * 64 + m * 16 + fr, lc, u.pn);
#pragma unroll
            for (int m = 0; m < 4; ++m) {
                const int row = u.pm * BM + ai * HALF + wr * 64 + m * 16 + fr;
                f.row(row, lc, u.pn, acc[ai][0][m][0], acc[ai][0][m][1], acc[ai][1][m][0], acc[ai][1][m][1], fq, s0, s1, pre[m]);
            }
        }
        f.finish(u.pn, wc, s0, s1);
    }
};
struct F1 {
    typedef NoPre Pre; __device__ __forceinline__ Pre pre(int, int, int) const { return Pre{}; }
    bf16_t *QA, *KA, *VA, *CQ, *CKV, *KR, *GA, *GB; float *ssq_q, *ssq_kv; const float *rc, *rs; unsigned* knmax;
    __device__ __forceinline__ void finish(int pn, int wc, float s0, float s1) const { if (pn == 9 && wc == 0) { const float m = frmax(s0); if (lane_now() == 0) atomicMax(knmax + 32, __float_as_uint(m)); } }
    __device__ __forceinline__ void row(int row, int lc, int pn, f32x4 a0, f32x4 a1, f32x4 b0, f32x4 b1, int fq, float& s0, float& s1, const Pre& P) const {
        if (pn < 4) { bf16_t* p = QA + (size_t)row * 1024 + pn * 256 + lc; st8(p, a0, a1); st8(p + 128, b0, b1); }
        else if (pn == 4) { bf16_t* p = KA + (size_t)row * 256 + lc; st8(p, a0, a1); st8(p + 128, b0, b1); }
        else if (pn == 5) { bf16_t* p = VA + (size_t)row * 256 + lc; st8(p, a0, a1); st8(p + 128, b0, b1); }
        else if (pn < 8) { bf16_t* p = CQ + (size_t)row * 512 + (pn - 6) * 256 + lc; st8(p, a0, a1); st8(p + 128, b0, b1);
            const float s = rowred((sq4(a0) + sq4(a1)) + (sq4(b0) + sq4(b1))); if (fq == 0) unsafeAtomicAdd(ssq_q + row, s); }
        else if (pn == 8) { bf16_t* p = CKV + (size_t)row * 256 + lc; st8(p, a0, a1); st8(p + 128, b0, b1);
            const float s = rowred((sq4(a0) + sq4(a1)) + (sq4(b0) + sq4(b1))); if (fq == 0) unsafeAtomicAdd(ssq_kv + row, s); }
        else if (pn == 9) { if (lc < 32) { rope8(a0, a1, rc + (size_t)row * 16 + 4 * fq, rs + (size_t)row * 16 + 4 * fq); st8(KR + (size_t)row * 32 + lc, a0, a1); s0 = fmaxf(s0, rowred(sq4(a0) + sq4(a1))); } }
        else if (pn < 18) { bf16_t* p = GA + (size_t)row * 2048 + (pn - 10) * 256 + lc; st8(p, sigm4(a0), sigm4(a1)); st8(p + 128, sigm4(b0), sigm4(b1)); }
        else { bf16_t* p = GB + (size_t)row * 2048 + (pn - 18) * 256 + lc; st8(p, sigm4(a0), sigm4(a1)); st8(p + 128, sigm4(b0), sigm4(b1)); }
    }
};
struct F2a {
    bf16_t* Q; const float* ssq_q; const float *rc, *rs; NOFIN
    struct Pre { float q; }; __device__ __forceinline__ Pre pre(int row, int, int) const { return Pre{ssq_q[row]}; }
    __device__ __forceinline__ void row(int row, int lc, int pn, f32x4 a0, f32x4 a1, f32x4 b0, f32x4 b1, int fq, float& s0, float& s1, const Pre& P) const {
        const float rstd = __builtin_amdgcn_rsqf(P.q * (1.0f / 512.0f) + RMS_EPS) * (0.10206207261596575f * 1.4426950408889634f);
        a0 *= rstd; a1 *= rstd; b0 *= rstd; b1 *= rstd;
        if (pn < 4) { bf16_t* p = Q + (size_t)row * 1536 + pn * 256 + lc; st8(p, a0, a1); st8(p + 128, b0, b1); }
        else { const float* c = rc + (size_t)row * 16 + 4 * fq; const float* s = rs + (size_t)row * 16 + 4 * fq; rope8(a0, a1, c, s); rope8(b0, b1, c, s);
            bf16_t* p = Q + (size_t)row * 1536 + 1024 + (pn - 4) * 256 + lc; st8(p, a0, a1); st8(p + 128, b0, b1); }
    }
};
struct F2b {
    struct Pre { float q; }; __device__ __forceinline__ Pre pre(int row, int, int) const { return Pre{ssq_kv[row]}; }
    bf16_t *KN, *V; const float* ssq_kv; unsigned* knmax;
    __device__ __forceinline__ void finish(int pn, int wc, float s0, float s1) const { if (pn < 4) { const float m0 = frmax(s0), m1 = frmax(s1);
        if (lane_now() == 0) { atomicMax(knmax + (pn * 4 + (wc >> 1)) * 2 + (wc & 1), __float_as_uint(m0)); atomicMax(knmax + (pn * 4 + 2 + (wc >> 1)) * 2 + (wc & 1), __float_as_uint(m1)); } } }
    __device__ __forceinline__ void row(int row, int lc, int pn, f32x4 a0, f32x4 a1, f32x4 b0, f32x4 b1, int fq, float& s0, float& s1, const Pre& P) const {
        const float rstd = __builtin_amdgcn_rsqf(P.q * (1.0f / 256.0f) + RMS_EPS);
        a0 *= rstd; a1 *= rstd; b0 *= rstd; b1 *= rstd;
        bf16_t* p = (pn < 4 ? KN + pn * 256 : V + (pn - 4) * 256) + (size_t)row * 1024 + lc; st8(p, a0, a1); st8(p + 128, b0, b1);
        if (pn < 4) { s0 = fmaxf(s0, rowred(sq4(a0) + sq4(a1))); s1 = fmaxf(s1, rowred(sq4(b0) + sq4(b1))); }
    }
};
struct F4a {
    const bf16_t* G; bf16_t* T1; NOFIN
    struct Pre { u32x4 g0, g1; }; __device__ __forceinline__ Pre pre(int row, int lc, int pn) const { const size_t off = (size_t)row * 2048 + pn * 256 + lc; return Pre{__builtin_nontemporal_load((const u32x4*)(G + off)), __builtin_nontemporal_load((const u32x4*)(G + off + 128))}; }
    __device__ __forceinline__ void row(int row, int lc, int pn, f32x4 a0, f32x4 a1, f32x4 b0, f32x4 b1, int fq, float& s0, float& s1, const Pre& P) const {
        const size_t off = (size_t)row * 2048 + pn * 256 + lc; f32x4 g0, g1, g2, g3; up8(P.g0, g0, g1); up8(P.g1, g2, g3);
        st8(T1 + off, a0 * g0, a1 * g1); st8(T1 + off + 128, b0 * g2, b1 * g3);
    }
};
struct F4b {
    const bf16_t *G, *T1; bf16_t* MG; NOFIN
    struct Pre { u32x4 g0, g1, t0, t1; }; __device__ __forceinline__ Pre pre(int row, int lc, int pn) const { const size_t off = (size_t)row * 2048 + pn * 256 + lc; return Pre{__builtin_nontemporal_load((const u32x4*)(G + off)), __builtin_nontemporal_load((const u32x4*)(G + off + 128)), *(const u32x4*)(T1 + off), *(const u32x4*)(T1 + off + 128)}; }
    __device__ __forceinline__ void row(int row, int lc, int pn, f32x4 a0, f32x4 a1, f32x4 b0, f32x4 b1, int fq, float& s0, float& s1, const Pre& P) const {
        const size_t off = (size_t)row * 2048 + pn * 256 + lc; f32x4 g0, g1, g2, g3, t0, t1, t2, t3; up8(P.g0, g0, g1); up8(P.g1, g2, g3); up8(P.t0, t0, t1); up8(P.t1, t2, t3);
        st8(MG + off, t0 + a0 * g0, t1 + a1 * g1); st8(MG + off + 128, t2 + b0 * g2, t3 + b1 * g3);
    }
};
template <bool WITH_BF16> struct FRes {
    const float* X; float* O; bf16_t* XB; float* ssq; NOFIN
    struct Pre { f32x4 x0, x1, x2, x3; }; __device__ __forceinline__ Pre pre(int row, int lc, int pn) const { const size_t off = (size_t)row * 2048 + pn * 256 + lc; return Pre{__builtin_nontemporal_load((const f32x4*)(X + off)), __builtin_nontemporal_load((const f32x4*)(X + off + 4)), __builtin_nontemporal_load((const f32x4*)(X + off + 128)), __builtin_nontemporal_load((const f32x4*)(X + off + 132))}; }
    __device__ __forceinline__ void row(int row, int lc, int pn, f32x4 a0, f32x4 a1, f32x4 b0, f32x4 b1, int fq, float& s0, float& s1, const Pre& P) const {
        const size_t off = (size_t)row * 2048 + pn * 256 + lc;
        a0 += P.x0; a1 += P.x1; b0 += P.x2; b1 += P.x3;
        *(f32x4*)(O + off) = a0; *(f32x4*)(O + off + 4) = a1; *(f32x4*)(O + off + 128) = b0; *(f32x4*)(O + off + 132) = b1;
        if (WITH_BF16) { st8(XB + off, a0, a1); st8(XB + off + 128, b0, b1); }
        const float s = rowred((sq4(a0) + sq4(a1)) + (sq4(b0) + sq4(b1))); if (fq == 0) unsafeAtomicAdd(ssq + row, s);
    }
};
struct F7 {
    bf16_t* U; const float* ssq; NOFIN
    struct Pre { float q; }; __device__ __forceinline__ Pre pre(int row, int, int) const { return Pre{ssq[row]}; }
    __device__ __forceinline__ void row(int row, int lc, int pn, f32x4 a0, f32x4 a1, f32x4 b0, f32x4 b1, int fq, float& s0, float& s1, const Pre& P) const {
        const float rstd = __builtin_amdgcn_rsqf(P.q * (1.0f / 2048.0f) + RMS_EPS);
        const f32x4 z = {0.f, 0.f, 0.f, 0.f};
        a0 = __builtin_elementwise_max(a0 * rstd, z); a1 = __builtin_elementwise_max(a1 * rstd, z); b0 = __builtin_elementwise_max(b0 * rstd, z); b1 = __builtin_elementwise_max(b1 * rstd, z);
        bf16_t* p = U + (size_t)row * 8192 + pn * 256 + lc; st8(p, a0 * a0, a1 * a1); st8(p + 128, b0 * b0, b1 * b1);
    }
};
template <class Epi, class Sched, bool ALIGN_EPI = false, bool SP2 = false>
__device__ __forceinline__ void gemm_phase(PG8_LAS unsigned char* lds, const Gemm g, const Sched& S, const Epi& E, const int wv  ) {
    const int tid_ = (wv << 6) | lane_now();
    const int tid = tid_, wid = __builtin_amdgcn_readfirstlane(tid >> 6), lane = tid & 63, wr = wid >> 2, wc = wid & 3, fr = lane & 15, fq = lane >> 4;
    const int K = g.K, nt = K / BK;
    unsigned voffA[2], voffB[2];
#pragma unroll
    for (int i = 0; i < 2; ++i) { int R, C; stage_rc(tid * 16 + i * 8192, R, C); const int Rb = Epi::PERM ? ((R & ~31) + perm32(R & 31)) : R;
        voffA[i] = (unsigned)(R * K + C) * 2u; voffB[i] = (unsigned)(Rb * K + C) * 2u; }
    const size_t kstep = (size_t)(BK * 2);
    const size_t hstep = (size_t)HALF * K * 2;
    const size_t tstep = 2 * hstep;
    const unsigned ldsw = (unsigned)wid * 1024u;
    const int aoff = lds_byte(wr * 64 + fr, fq * 8), boff = lds_byte(wc * 32 + fr, fq * 8);
#define PG8_SA(b, h) (((b) * 2 + (h)) * HTB)
#define PG8_SB(b, h) ((4 + (b) * 2 + (h)) * HTB)
#define PG8_STAGE(bufoff, gbase, voff) do { _Pragma("unroll") for (int _i = 0; _i < 2; ++_i) \
        __builtin_amdgcn_global_load_lds((const unsigned*)((const char*)(gbase) + (voff)[_i]), (PG8_LAS unsigned*)(lds + (bufoff) + ldsw + _i * 8192), 16, 0, 0); } while (0)
#define PG8_LDA(dst, b, h) do { _Pragma("unroll") for (int m = 0; m < 4; ++m) _Pragma("unroll") for (int k = 0; k < 2; ++k) dst[m][k] = *(const PG8_LAS bf16x8*)(lds + PG8_SA(b, h) + aoff + m * 2048 + k * 1024); } while (0)
#define PG8_LDB(dst, b, h) do { _Pragma("unroll") for (int n = 0; n < 2; ++n) _Pragma("unroll") for (int k = 0; k < 2; ++k) dst[n][k] = *(const PG8_LAS bf16x8*)(lds + PG8_SB(b, h) + boff + n * 2048 + k * 1024); } while (0)
#define PG8_MMA(ai, bj, At, Bt) do { __builtin_amdgcn_s_setprio(1); _Pragma("unroll") for (int m = 0; m < 4; ++m) _Pragma("unroll") for (int n = 0; n < 2; ++n) _Pragma("unroll") for (int k = 0; k < 2; ++k) \
        acc[ai][bj][m][n] = __builtin_amdgcn_mfma_f32_16x16x32_bf16(Bt[n][k], At[m][k], acc[ai][bj][m][n], 0, 0, 0); __builtin_amdgcn_s_setprio(0); } while (0)
#define PG8_WAIT_V(n) asm volatile("s_waitcnt vmcnt(" #n ")" ::: "memory")
#define PG8_WAIT_L(n) asm volatile("s_waitcnt lgkmcnt(" #n ")" ::: "memory")
#define PG8_BAR __builtin_amdgcn_s_barrier()
#define PG8_SCHED __builtin_amdgcn_sched_barrier(0)
    Unit cur, nxt; int ui = 0;
    if (!S.next(0, cur)) return;
    f32x4 acc[2][2][4][2];
#pragma unroll
    for (int a = 0; a < 2; ++a)
#pragma unroll
        for (int b = 0; b < 2; ++b)
#pragma unroll
            for (int m = 0; m < 4; ++m)
#pragma unroll
                for (int n = 0; n < 2; ++n) acc[a][b][m][n] = (f32x4){0.f, 0.f, 0.f, 0.f};
    bf16x8 At[4][2], B0[2][2], B1[2][2];
    const char* cA = (const char*)g.A + (size_t)cur.pm * tstep; const char* cB = (const char*)g.Bt + (size_t)cur.pn * tstep;
    S.a_ready(cur);
    if constexpr (SP2) {
        PG8_STAGE(PG8_SB(0, 0), cB, voffB); PG8_STAGE(PG8_SB(0, 1), cB + hstep, voffB); PG8_STAGE(PG8_SA(0, 0), cA, voffA); PG8_STAGE(PG8_SA(0, 1), cA + hstep, voffA);
        if (wr == 1) PG8_BAR;
        PG8_WAIT_V(2); PG8_BAR;
        PG8_STAGE(PG8_SB(1, 0), cB + kstep, voffB); PG8_STAGE(PG8_SA(1, 0), cA + kstep, voffA); PG8_STAGE(PG8_SB(1, 1), cB + hstep + kstep, voffB);
        PG8_WAIT_V(6); PG8_BAR;
    } else {
        PG8_STAGE(PG8_SB(0, 0), cB, voffB); PG8_STAGE(PG8_SA(0, 0), cA, voffA); PG8_STAGE(PG8_SB(0, 1), cB + hstep, voffB); PG8_STAGE(PG8_SA(0, 1), cA + hstep, voffA);
        if (wr == 1) PG8_BAR;
        PG8_WAIT_V(4); PG8_BAR;
        PG8_STAGE(PG8_SB(1, 0), cB + kstep, voffB); PG8_STAGE(PG8_SA(1, 0), cA + kstep, voffA); PG8_STAGE(PG8_SB(1, 1), cB + hstep + kstep, voffB);
        PG8_WAIT_V(6); PG8_BAR;
    }
    for (;;) {
        const bool has_next = S.next(ui + 1, nxt);
        const char* nA = has_next ? (const char*)g.A + (size_t)nxt.pm * tstep : cA; const char* nB = has_next ? (const char*)g.Bt + (size_t)nxt.pn * tstep : cB;
        for (int t = 0; t < nt; t += 2) {
            const bool last = (t == nt - 2);
            const char* a1 = cA + (size_t)(t + 1) * kstep;
            const char* a2 = last ? nA : cA + (size_t)(t + 2) * kstep; const char* b2 = last ? nB : cB + (size_t)(t + 2) * kstep;
            const char* a3 = a2 + kstep; const char* b3 = b2 + kstep;
            if (last && has_next) S.a_ready(nxt);
            if constexpr (SP2) {
            PG8_LDB(B0, 0, 0); PG8_LDB(B1, 0, 1); PG8_SCHED; PG8_LDA(At, 0, 0); PG8_STAGE(PG8_SA(1, 1), a1 + hstep, voffA);
            PG8_WAIT_V(8); PG8_WAIT_L(0); PG8_BAR; PG8_MMA(0, 0, At, B0); PG8_MMA(0, 1, At, B1); PG8_BAR; PG8_SCHED;
            PG8_LDA(At, 0, 1); PG8_STAGE(PG8_SB(0, 0), b2, voffB); PG8_STAGE(PG8_SB(0, 1), b2 + hstep, voffB); PG8_STAGE(PG8_SA(0, 0), a2, voffA);
            PG8_WAIT_V(8); PG8_WAIT_L(0); PG8_BAR; PG8_MMA(1, 0, At, B0); PG8_MMA(1, 1, At, B1); PG8_BAR; PG8_SCHED;
            PG8_LDB(B0, 1, 0); PG8_LDB(B1, 1, 1); PG8_SCHED; PG8_LDA(At, 1, 0); PG8_STAGE(PG8_SA(0, 1), a2 + hstep, voffA);
            PG8_WAIT_V(8); PG8_WAIT_L(0); PG8_BAR; PG8_MMA(0, 0, At, B0); PG8_MMA(0, 1, At, B1); PG8_BAR; PG8_SCHED;
            PG8_LDA(At, 1, 1); PG8_STAGE(PG8_SB(1, 0), b3, voffB); PG8_STAGE(PG8_SB(1, 1), b3 + hstep, voffB); PG8_STAGE(PG8_SA(1, 0), a3, voffA);
            PG8_WAIT_V(8); PG8_WAIT_L(0); PG8_BAR; PG8_MMA(1, 0, At, B0); PG8_MMA(1, 1, At, B1); PG8_BAR; PG8_SCHED;
            } else {
            PG8_LDB(B0, 0, 0); PG8_SCHED; PG8_LDA(At, 0, 0); PG8_STAGE(PG8_SA(1, 1), a1 + hstep, voffA);
            PG8_WAIT_L(8); PG8_BAR; PG8_WAIT_L(0); PG8_MMA(0, 0, At, B0); PG8_BAR; PG8_SCHED;
            PG8_LDB(B1, 0, 1); PG8_STAGE(PG8_SB(0, 0), b2, voffB);
            PG8_BAR; PG8_WAIT_L(0); PG8_MMA(0, 1, At, B1); PG8_BAR;
            PG8_LDA(At, 0, 1); PG8_STAGE(PG8_SA(0, 0), a2, voffA);
            PG8_BAR; PG8_WAIT_L(0); PG8_MMA(1, 0, At, B0); PG8_BAR; PG8_SCHED;
            PG8_STAGE(PG8_SB(0, 1), b2 + hstep, voffB);
            PG8_WAIT_V(6); PG8_BAR; PG8_MMA(1, 1, At, B1); PG8_BAR;
            PG8_LDB(B0, 1, 0); PG8_SCHED; PG8_LDA(At, 1, 0); PG8_STAGE(PG8_SA(0, 1), a2 + hstep, voffA);
            PG8_WAIT_L(8); PG8_BAR; PG8_WAIT_L(0); PG8_MMA(0, 0, At, B0); PG8_BAR; PG8_SCHED;
            PG8_LDB(B1, 1, 1); PG8_STAGE(PG8_SB(1, 0), b3, voffB);
            PG8_BAR; PG8_WAIT_L(0); PG8_MMA(0, 1, At, B1); PG8_BAR;
            PG8_LDA(At, 1, 1); PG8_STAGE(PG8_SA(1, 0), a3, voffA);
            PG8_BAR; PG8_WAIT_L(0); PG8_MMA(1, 0, At, B0); PG8_BAR; PG8_SCHED;
            PG8_STAGE(PG8_SB(1, 1), b3 + hstep, voffB);
            PG8_WAIT_V(6); PG8_BAR; PG8_MMA(1, 1, At, B1); PG8_BAR;
            }
        }
        if constexpr (ALIGN_EPI) { if (wr == 0) PG8_BAR; }
        if constexpr (!Epi::AFTER_DRAIN) { E(acc, cur, wr, wc, fr, fq); S.done(cur); }
        if (!has_next) break;
#pragma unroll
        for (int a = 0; a < 2; ++a)
#pragma unroll
            for (int b = 0; b < 2; ++b)
#pragma unroll
                for (int m = 0; m < 4; ++m)
#pragma unroll
                    for (int n = 0; n < 2; ++n) acc[a][b][m][n] = (f32x4){0.f, 0.f, 0.f, 0.f};
        cur = nxt; cA = nA; cB = nB; ++ui;
        if constexpr (ALIGN_EPI) { if (wr == 1) PG8_BAR; }
    }
    PG8_WAIT_V(0);
    if constexpr (!ALIGN_EPI) { if (wr == 0) PG8_BAR; }
    PG8_BAR;
    if constexpr (Epi::AFTER_DRAIN) { E.fused(acc, cur, wr, wc, fr, fq, lds, wid, lane); S.done(cur); }
#undef PG8_SA
#undef PG8_SB
#undef PG8_STAGE
#undef PG8_LDA
#undef PG8_LDB
#undef PG8_MMA
#undef PG8_WAIT_V
#undef PG8_WAIT_L
#undef PG8_BAR
#undef PG8_SCHED
}
}
namespace att {
typedef unsigned short bf16_t;
using bf16x8 = __attribute__((ext_vector_type(8))) short;
using s16x4  = __attribute__((ext_vector_type(4))) short;
using f32x16 = __attribute__((ext_vector_type(16))) float;
using u32x4  = __attribute__((ext_vector_type(4))) unsigned;
constexpr int NW = 8, QBLK = 32, KVBLK = 64;
constexpr int SHM_V = KVBLK * 64 * 2, SHM_K = KVBLK * 128 * 2, SHM_ATTN = 2 * SHM_V + 2 * SHM_K + NW * 64 * 4;
#define KSWZ(row, colB) ((row) * 256 + ((colB) ^ (((row) & 7) << 4)))
#define SBAR() __builtin_amdgcn_sched_barrier(0)
__device__ __forceinline__ int crow(int r, int hi) { return (r & 3) + 8 * (r >> 2) + 4 * hi; }
__device__ __forceinline__ unsigned cvtpk(float lo, float hi) { unsigned r; asm volatile("v_cvt_pk_bf16_f32 %0, %1, %2" : "=v"(r) : "v"(lo), "v"(hi)); return r; }
__device__ __forceinline__ void partialSM(f32x16& p0, f32x16& p1, float& m_reg, float& mn, float& alpha, const float C, const float thr) {
  float pmax = p0[0];
#pragma unroll
  for (int r = 1; r < 16; ++r) pmax = fmaxf(pmax, p0[r]);
#pragma unroll
  for (int r = 0; r < 16; ++r) pmax = fmaxf(pmax, p1[r]);
  { auto rr = __builtin_amdgcn_permlane32_swap(__float_as_uint(pmax), __float_as_uint(pmax), false, false);
    pmax = fmaxf(__uint_as_float(rr[0]), __uint_as_float(rr[1])); }
  if (__builtin_expect(__all(pmax - m_reg <= thr), 1)) { mn = m_reg; alpha = 1.f; }
  else { mn = fmaxf(m_reg, pmax); alpha = __builtin_amdgcn_exp2f((m_reg - mn) * C); m_reg = mn; }
  const float mnC = -mn * C;
#pragma unroll
  for (int r = 0; r < 16; ++r) p0[r] = fmaf(p0[r], C, mnC);
#pragma unroll
  for (int r = 0; r < 16; ++r) p1[r] = fmaf(p1[r], C, mnC);
#pragma unroll
  for (int r = 0; r < 16; ++r) p0[r] = __builtin_amdgcn_exp2f(p0[r]);
}
__device__ __forceinline__ void finishSM(f32x16& p0, f32x16& p1, float alpha, float& l_reg, bf16x8& pa0, bf16x8& pa1, bf16x8& pa2, bf16x8& pa3) {
#pragma unroll
  for (int r = 0; r < 16; ++r) p1[r] = __builtin_amdgcn_exp2f(p1[r]);
  float ps = 0;
#pragma unroll
  for (int r = 0; r < 16; ++r) ps += p0[r];
#pragma unroll
  for (int r = 0; r < 16; ++r) ps += p1[r];
  { auto rr = __builtin_amdgcn_permlane32_swap(__float_as_uint(ps), __float_as_uint(ps), false, false);
    ps = __uint_as_float(rr[0]) + __uint_as_float(rr[1]); }
  l_reg = l_reg * alpha + ps;
#define PK4(P, BASE, OUT) do { unsigned a0 = cvtpk(P[BASE + 0], P[BASE + 1]), a1 = cvtpk(P[BASE + 2], P[BASE + 3]);   \
    unsigned b0 = cvtpk(P[BASE + 4], P[BASE + 5]), b1 = cvtpk(P[BASE + 6], P[BASE + 7]);                              \
    auto r0 = __builtin_amdgcn_permlane32_swap(a0, b0, false, false); auto r1 = __builtin_amdgcn_permlane32_swap(a1, b1, false, false); \
    u32x4 w = {r0[0], r1[0], r0[1], r1[1]}; OUT = *reinterpret_cast<bf16x8*>(&w); } while (0)
  PK4(p0, 0, pa0); PK4(p0, 8, pa1); PK4(p1, 0, pa2); PK4(p1, 8, pa3);
#undef PK4
}
template <int NQD> __device__ __forceinline__ void qkt(f32x16& p0, f32x16& p1, const char* Ks, const bf16x8* qr, int r32, int hi) {
  p0 = f32x16{}; p1 = f32x16{};
#pragma unroll
  for (int d0 = 0; d0 < NQD; ++d0) { const int cb = (d0 * 16 + hi * 8) * 2;
    const bf16x8 b0 = *reinterpret_cast<const bf16x8*>(Ks + KSWZ(r32, cb));
    const bf16x8 b1 = *reinterpret_cast<const bf16x8*>(Ks + KSWZ(32 + r32, cb));
    p0 = __builtin_amdgcn_mfma_f32_32x32x16_bf16(b0, qr[d0], p0, 0, 0, 0);
    p1 = __builtin_amdgcn_mfma_f32_32x32x16_bf16(b1, qr[d0], p1, 0, 0, 0); }
}
__device__ __forceinline__ int v_st(int k, int c) { const int kk = (k & ~0xC) | ((k & 4) << 1) | ((k & 8) >> 1); return ((kk >> 3) * 2 + (c >> 5)) * 512 + ((kk & 7) * 32 + (c & 31)) * 2; }
__device__ __forceinline__ int v_rd_base(int lane) { return ((lane & 3) << 3) | (((lane >> 2) & 3) << 6) | (((lane >> 4) & 1) << 5) | (((lane >> 5) & 1) << 8); }
constexpr int v_rd_off(int d0, int ks, int half) { return d0 * 512 + ks * 2048 + half * 1024; }
template <int OFF> __device__ __forceinline__ s16x4 tr_read(int vb) {
  s16x4 r; asm volatile("ds_read_b64_tr_b16 %0, %1 offset:%2" : "=&v"(r) : "v"(vb), "i"(OFF) : "memory"); return r;
}
template <int D0> __device__ __forceinline__ void pv_one(f32x16& od, int vb, bf16x8 pa0, bf16x8 pa1, bf16x8 pa2, bf16x8 pa3) {
  const s16x4 l0 = tr_read<v_rd_off(D0, 0, 0)>(vb), h0 = tr_read<v_rd_off(D0, 0, 1)>(vb), l1 = tr_read<v_rd_off(D0, 1, 0)>(vb), h1 = tr_read<v_rd_off(D0, 1, 1)>(vb);
  const s16x4 l2 = tr_read<v_rd_off(D0, 2, 0)>(vb), h2 = tr_read<v_rd_off(D0, 2, 1)>(vb), l3 = tr_read<v_rd_off(D0, 3, 0)>(vb), h3 = tr_read<v_rd_off(D0, 3, 1)>(vb);
  asm volatile("s_waitcnt lgkmcnt(0)" ::: "memory"); SBAR();
#define PK(L, H) (bf16x8){L[0], L[1], L[2], L[3], H[0], H[1], H[2], H[3]}
  od = __builtin_amdgcn_mfma_f32_32x32x16_bf16(pa0, PK(l0, h0), od, 0, 0, 0);
  od = __builtin_amdgcn_mfma_f32_32x32x16_bf16(pa1, PK(l1, h1), od, 0, 0, 0);
  od = __builtin_amdgcn_mfma_f32_32x32x16_bf16(pa2, PK(l2, h2), od, 0, 0, 0);
  od = __builtin_amdgcn_mfma_f32_32x32x16_bf16(pa3, PK(l3, h3), od, 0, 0, 0);
#undef PK
}
__device__ __forceinline__ void pv2(f32x16* o, int vb, bf16x8 pa0, bf16x8 pa1, bf16x8 pa2, bf16x8 pa3) {
  pv_one<0>(o[0], vb, pa0, pa1, pa2, pa3); pv_one<1>(o[1], vb, pa0, pa1, pa2, pa3);
}
struct Tensors { const bf16_t *Q, *KN, *KR, *V; bf16_t* O; const int* pos; const float* sink; };
constexpr int SEQ = 16384;
template <int MODE>
__device__ __forceinline__ void unit(const Tensors& T, int h, int qb, char* lds, const int wv) {
  constexpr int NQD = MODE == 0 ? 6 : 4;
  constexpr int LDQ = MODE == 0 ? 1536 : 1024, LDK = MODE == 0 ? 1024 : 256, LDO = 1024;
  constexpr float SCALE = MODE == 0 ? 0.10206207261596575f : 0.125f;
  constexpr float C = SCALE * 1.4426950408889634f;
  constexpr float CM = 1.0f, THRS = 11.5f;
  const int tid_ = (wv << 6) | lane_now();
  const int tid = tid_, wid = tid >> 6, lane = tid & 63, r32 = lane & 31, hi = lane >> 5;
  char* V_lds = lds; char* K_lds = lds + 2 * SHM_V;
  float* ws = (float*)(lds + 2 * SHM_V + 2 * SHM_K) + wid * 64; float* li_l = ws; float* al_l = ws + 32;
  const int q0 = qb * 256, kh = MODE == 0 ? h : (h >> 2);
  const bf16_t* Kn = T.KN + kh * 64; const bf16_t* Vh = T.V + kh * 64;
  const int qi = q0 + wid * QBLK + r32;
  const bf16_t* Qw = T.Q + (size_t)qi * LDQ + hi * 8;
  bf16x8 qr[NQD];
#pragma unroll
  for (int d0 = 0; d0 < 4; ++d0) qr[d0] = *reinterpret_cast<const bf16x8*>(Qw + h * 64 + d0 * 16);
  if constexpr (MODE == 0) {
#pragma unroll
    for (int d0 = 4; d0 < 6; ++d0) qr[d0] = *reinterpret_cast<const bf16x8*>(Qw + 1024 + h * 32 + (d0 - 4) * 16);
  }
  float m_reg = -1e30f, l_reg = 0.f; int posq = 0; float slope2 = 0.f;
  if constexpr (MODE == 1) { m_reg = T.sink[h] * 1.4426950408889634f; l_reg = 1.0f; posq = T.pos[qi]; slope2 = __builtin_amdgcn_exp2f(-0.5f * (float)(h + 1)) * 1.4426950408889634f; }
  int t_lo = 0, NT = SEQ / KVBLK;
  if constexpr (MODE == 1) { t_lo = 4 * qb - 2; int t_hi = 4 * qb + 6; if (t_lo < 0) t_lo = 0; if (t_hi > SEQ / KVBLK) t_hi = SEQ / KVBLK; NT = t_hi - t_lo; }
  f32x16 o[2] = {};
  const int sr = tid >> 3, sc = (tid & 7) * 8;
  const int vst = v_st(sr, sc), kst = KSWZ(sr, sc * 2), krst = KSWZ(sr, 128 + (tid & 7) * 8);
  const int vb0 = (int)(uintptr_t)V_lds + v_rd_base(lane);
  bf16x8 vsA, ksA, vsB, ksB; s16x4 krA = {}, krB = {};
#define SLOAD(VS, KS, KRR, tt) do { const size_t k0_ = (size_t)(t_lo + (tt)) * KVBLK + sr; VS = *reinterpret_cast<const bf16x8*>(Vh + k0_ * LDK + sc); KS = *reinterpret_cast<const bf16x8*>(Kn + k0_ * LDK + sc); \
    if constexpr (MODE == 0) KRR = *reinterpret_cast<const s16x4*>(T.KR + k0_ * 32 + (tid & 7) * 4); } while (0)
#define SWRITE(b, VS, KS, KRR) do { *(bf16x8*)(V_lds + (b) * SHM_V + vst) = VS; *(bf16x8*)(K_lds + (b) * SHM_K + kst) = KS; \
    if constexpr (MODE == 0) *(s16x4*)(K_lds + (b) * SHM_K + krst) = KRR; } while (0)
#define SWAIT() do { if constexpr (MODE == 0) asm volatile("s_waitcnt vmcnt(3)" ::: "memory"); else asm volatile("s_waitcnt vmcnt(2)" ::: "memory"); } while (0)
#define RESC(a) do { if (__any((a) < 1.f)) { if (hi == 0) al_l[r32] = (a); asm volatile("s_waitcnt lgkmcnt(0)" ::: "memory"); \
    _Pragma("unroll") for (int d = 0; d < 2; ++d) _Pragma("unroll") for (int r = 0; r < 16; ++r) o[d][r] *= al_l[crow(r, hi)]; } } while (0)
#define BIAS(P0, P1, tt) do { if constexpr (MODE == 1) { const int kb_ = (t_lo + (tt)) * KVBLK; \
    _Pragma("unroll") for (int g = 0; g < 4; ++g) { \
      const int4 pk0_ = *reinterpret_cast<const int4*>(T.pos + kb_ + 8 * g + 4 * hi), pk1_ = *reinterpret_cast<const int4*>(T.pos + kb_ + 32 + 8 * g + 4 * hi); \
      const int pv0_[4] = {pk0_.x, pk0_.y, pk0_.z, pk0_.w}, pv1_[4] = {pk1_.x, pk1_.y, pk1_.z, pk1_.w}; \
      _Pragma("unroll") for (int e = 0; e < 4; ++e) { const int r = 4 * g + e; const int k0_ = kb_ + 8 * g + 4 * hi + e, k1_ = k0_ + 32; \
        const float d0_ = (float)abs(posq - pv0_[e]), d1_ = (float)abs(posq - pv1_[e]); \
        P0[r] = (abs(qi - k0_) <= 128) ? fmaf(P0[r], C, -slope2 * d0_) : -1e30f; \
        P1[r] = (abs(qi - k1_) <= 128) ? fmaf(P1[r], C, -slope2 * d1_) : -1e30f; } } } } while (0)
  f32x16 pA0, pA1, pB0, pB1; float mnA, mnB, alA, alB; bf16x8 pa0, pa1, pa2, pa3;
  SLOAD(vsA, ksA, krA, 0); asm volatile("s_waitcnt vmcnt(0)" ::: "memory"); SWRITE(0, vsA, ksA, krA); __syncthreads();
  qkt<NQD>(pA0, pA1, K_lds, qr, r32, hi); BIAS(pA0, pA1, 0); partialSM(pA0, pA1, m_reg, mnA, alA, CM, THRS);
  SLOAD(vsB, ksB, krB, 1); if (2 < NT) SLOAD(vsA, ksA, krA, 2);
  SWAIT(); SWRITE(1, vsB, ksB, krB); __syncthreads();
  for (int j = 1; j + 1 < NT; j += 2) {
    SBAR(); qkt<NQD>(pB0, pB1, K_lds + SHM_K, qr, r32, hi); BIAS(pB0, pB1, j);
    finishSM(pA0, pA1, alA, l_reg, pa0, pa1, pa2, pa3); SBAR();
    SLOAD(vsB, ksB, krB, j + 2); SBAR();
    pv2(o, vb0, pa0, pa1, pa2, pa3); partialSM(pB0, pB1, m_reg, mnB, alB, CM, THRS);
    __syncthreads(); SWAIT(); SWRITE(0, vsA, ksA, krA);
    RESC(alB); __syncthreads();
    SBAR(); qkt<NQD>(pA0, pA1, K_lds, qr, r32, hi); BIAS(pA0, pA1, j + 1);
    finishSM(pB0, pB1, alB, l_reg, pa0, pa1, pa2, pa3); SBAR();
    if (j + 3 < NT) SLOAD(vsA, ksA, krA, j + 3); SBAR();
    pv2(o, vb0 + SHM_V, pa0, pa1, pa2, pa3); partialSM(pA0, pA1, m_reg, mnA, alA, CM, THRS);
    __syncthreads(); SWAIT(); SWRITE(1, vsB, ksB, krB);
    RESC(alA); __syncthreads();
  }
  SBAR(); qkt<NQD>(pB0, pB1, K_lds + SHM_K, qr, r32, hi); BIAS(pB0, pB1, NT - 1);
  finishSM(pA0, pA1, alA, l_reg, pa0, pa1, pa2, pa3); SBAR();
  pv2(o, vb0, pa0, pa1, pa2, pa3); partialSM(pB0, pB1, m_reg, mnB, alB, CM, THRS);
  __syncthreads(); RESC(alB);
  finishSM(pB0, pB1, alB, l_reg, pa0, pa1, pa2, pa3); SBAR();
  pv2(o, vb0 + SHM_V, pa0, pa1, pa2, pa3);
  if (hi == 0) li_l[r32] = l_reg; asm volatile("s_waitcnt lgkmcnt(0)" ::: "memory");
  float rli[16];
#pragma unroll
  for (int r = 0; r < 16; ++r) rli[r] = __builtin_amdgcn_rcpf(li_l[crow(r, hi)]);
  bf16_t* Ow = T.O + (size_t)(q0 + wid * QBLK) * LDO + h * 64;
#pragma unroll
  for (int r = 0; r < 16; ++r) { const int orow = crow(r, hi);
#pragma unroll
    for (int d0 = 0; d0 < 2; ++d0) { const float v = o[d0][r] * rli[r]; Ow[(size_t)orow * LDO + d0 * 32 + r32] = (bf16_t)(cvtpk(v, v) & 0xffffu); } }
  __syncthreads();
#undef SLOAD
#undef SWRITE
#undef SWAIT
#undef RESC
#undef BIAS
}

__device__ __forceinline__ bool unit_fast(const Tensors& T, const unsigned* knmax, int h, int qb, char* lds, const int wv) {
  constexpr int NQD = 6, LDQ = 1536, LDK = 1024, LDO = 1024;
  const int tid_ = (wv << 6) | lane_now();
  const int tid = tid_, wid = tid >> 6, lane = tid & 63, r32 = lane & 31, hi = lane >> 5;
  char* V_lds = lds; char* K_lds = lds + 2 * SHM_V;
  float* ws = (float*)(lds + 2 * SHM_V + 2 * SHM_K) + wid * 64; float* li_l = ws;
  const int q0 = qb * 256;
  const bf16_t* Kn = T.KN + h * 64; const bf16_t* Vh = T.V + h * 64;
  const int qi = q0 + wid * QBLK + r32;
  const bf16_t* Qw = T.Q + (size_t)qi * LDQ + hi * 8;
  bf16x8 qr[NQD];
#pragma unroll
  for (int d0 = 0; d0 < 4; ++d0) qr[d0] = *reinterpret_cast<const bf16x8*>(Qw + h * 64 + d0 * 16);
#pragma unroll
  for (int d0 = 4; d0 < 6; ++d0) qr[d0] = *reinterpret_cast<const bf16x8*>(Qw + 1024 + h * 32 + (d0 - 4) * 16);
  float qn2 = 0.f;
#pragma unroll
  for (int d0 = 0; d0 < NQD; ++d0)
#pragma unroll
    for (int e = 0; e < 8; ++e) { const float v = __uint_as_float(((unsigned)(unsigned short)qr[d0][e]) << 16); qn2 += v * v; }
  { auto rr = __builtin_amdgcn_permlane32_swap(__float_as_uint(qn2), __float_as_uint(qn2), false, false); qn2 = __uint_as_float(rr[0]) + __uint_as_float(rr[1]); }
  size_t kz_ = 0; asm volatile("" : "+s"(kz_)); const unsigned* kmp = knmax + kz_;
  const float kn2 = __uint_as_float(kmp[2 * h]) + __uint_as_float(kmp[2 * h + 1]) + __uint_as_float(kmp[32]);
  const float mb = sqrtf(qn2 * kn2) * 1.01f + 1.0f;
  f32x16 negm;
#pragma unroll
  for (int r = 0; r < 16; ++r) negm[r] = -mb;
  asm volatile("" : "+v"(negm));
  float l_reg = 0.f;
  constexpr int NT = SEQ / KVBLK;
  f32x16 o[2] = {};
  const int sr = tid >> 3, sc = (tid & 7) * 8;
  const int vst = v_st(sr, sc), kst = KSWZ(sr, sc * 2), krst = KSWZ(sr, 128 + (tid & 7) * 8);
  const int vb0 = (int)(uintptr_t)V_lds + v_rd_base(lane);
  bf16x8 vsR, ksR; s16x4 krR;
#define SLOADK(tt) do { const size_t k0_ = (size_t)(tt) * KVBLK + sr; ksR = *reinterpret_cast<const bf16x8*>(Kn + k0_ * LDK + sc); krR = *reinterpret_cast<const s16x4*>(T.KR + k0_ * 32 + (tid & 7) * 4); } while (0)
#define SLOADV(tt) do { const size_t k0_ = (size_t)(tt) * KVBLK + sr; vsR = *reinterpret_cast<const bf16x8*>(Vh + k0_ * LDK + sc); } while (0)
#define SWRITEK(b) do { *(bf16x8*)(K_lds + (b) * SHM_K + kst) = ksR; *(s16x4*)(K_lds + (b) * SHM_K + krst) = krR; } while (0)
#define SWRITEV(b) do { *(bf16x8*)(V_lds + (b) * SHM_V + vst) = vsR; } while (0)
#ifndef ATT_PRIO
#define ATT_PRIO 1
#endif
#define PRIO_HI() do { if (ATT_PRIO) __builtin_amdgcn_s_setprio(ATT_PRIO); } while (0)
#ifndef ATT_PRIO2
#define ATT_PRIO2 0
#endif
#define PRIO2_HI() do { if (ATT_PRIO2) __builtin_amdgcn_s_setprio(ATT_PRIO2); } while (0)
#define PRIO2_LO() do { if (ATT_PRIO2) __builtin_amdgcn_s_setprio(0); } while (0)
#ifndef ATT_PRIOM
#define ATT_PRIOM 0
#endif
#define PRIO_MID() do { if (ATT_PRIOM) __builtin_amdgcn_s_setprio(0); } while (0)
#define PRIO_LO() do { if (ATT_PRIO) __builtin_amdgcn_s_setprio(0); } while (0)
#define QKT(P0, P1, Ks) do { \
    _Pragma("unroll") for (int d0 = 0; d0 < NQD; ++d0) { const int cb = (d0 * 16 + hi * 8) * 2; \
      const bf16x8 b0 = *reinterpret_cast<const bf16x8*>((Ks) + KSWZ(r32, cb)); const bf16x8 b1 = *reinterpret_cast<const bf16x8*>((Ks) + KSWZ(32 + r32, cb)); \
      if (d0 == 0) { P0 = __builtin_amdgcn_mfma_f32_32x32x16_bf16(b0, qr[0], negm, 0, 0, 0); P1 = __builtin_amdgcn_mfma_f32_32x32x16_bf16(b1, qr[0], negm, 0, 0, 0); } \
      else { P0 = __builtin_amdgcn_mfma_f32_32x32x16_bf16(b0, qr[d0], P0, 0, 0, 0); P1 = __builtin_amdgcn_mfma_f32_32x32x16_bf16(b1, qr[d0], P1, 0, 0, 0); } } } while (0)
#define EXPH(P) do { _Pragma("unroll") for (int r = 0; r < 16; ++r) P[r] = __builtin_amdgcn_exp2f(P[r]); } while (0)
#define PK4(P, BASE, OUT) do { unsigned a0 = cvtpk(P[BASE + 0], P[BASE + 1]), a1 = cvtpk(P[BASE + 2], P[BASE + 3]);   \
    unsigned b0 = cvtpk(P[BASE + 4], P[BASE + 5]), b1 = cvtpk(P[BASE + 6], P[BASE + 7]);                              \
    auto r0 = __builtin_amdgcn_permlane32_swap(a0, b0, false, false); auto r1 = __builtin_amdgcn_permlane32_swap(a1, b1, false, false); \
    u32x4 w = {r0[0], r1[0], r0[1], r1[1]}; OUT = *reinterpret_cast<bf16x8*>(&w); } while (0)
#ifndef EXP_ALL_IN_FIN
#define EXP_ALL_IN_FIN 0
#endif
#define EXPC(P) do { if (!EXP_ALL_IN_FIN) EXPH(P); } while (0)
#define FIN(P0, P1) do { if (EXP_ALL_IN_FIN) EXPH(P0); EXPH(P1); float ps = 0.f; _Pragma("unroll") for (int r = 0; r < 16; ++r) ps += P0[r]; _Pragma("unroll") for (int r = 0; r < 16; ++r) ps += P1[r]; l_reg += ps; \
    PK4(P0, 0, pa0); PK4(P0, 8, pa1); PK4(P1, 0, pa2); PK4(P1, 8, pa3); } while (0)
  f32x16 pA0, pA1, pB0, pB1; bf16x8 pa0, pa1, pa2, pa3;
  SLOADK(0); asm volatile("s_waitcnt vmcnt(0)" ::: "memory"); SWRITEK(0); SLOADK(1); SLOADV(0); __syncthreads();
  SWRITEK(1); SWRITEV(0); SLOADK(2); SLOADV(1);
  SBAR(); QKT(pA0, pA1, K_lds); EXPC(pA0);
  for (int t = 1; t + 1 < NT; t += 2) {
    __syncthreads();
    SWRITEK(0); SWRITEV(1); SLOADK(t + 2); SLOADV(t + 1);
    SBAR(); PRIO_HI(); QKT(pB0, pB1, K_lds + SHM_K); PRIO_MID();
    FIN(pA0, pA1); PRIO_LO(); SBAR();
    PRIO2_HI(); pv2(o, vb0, pa0, pa1, pa2, pa3); PRIO2_LO(); EXPC(pB0);
    __syncthreads();
    SWRITEK(1); SWRITEV(0); if (t + 3 < NT) SLOADK(t + 3); SLOADV(t + 2);
    SBAR(); PRIO_HI(); QKT(pA0, pA1, K_lds); PRIO_MID();
    FIN(pB0, pB1); PRIO_LO(); SBAR();
    PRIO2_HI(); pv2(o, vb0 + SHM_V, pa0, pa1, pa2, pa3); PRIO2_LO(); EXPC(pA0);
  }
  __syncthreads();
  SWRITEV(1);
  SBAR(); QKT(pB0, pB1, K_lds + SHM_K);
  FIN(pA0, pA1); SBAR();
  pv2(o, vb0, pa0, pa1, pa2, pa3); EXPC(pB0);
  __syncthreads();
  FIN(pB0, pB1); SBAR();
  pv2(o, vb0 + SHM_V, pa0, pa1, pa2, pa3);
  { auto rr = __builtin_amdgcn_permlane32_swap(__float_as_uint(l_reg), __float_as_uint(l_reg), false, false); l_reg = __uint_as_float(rr[0]) + __uint_as_float(rr[1]); }
  volatile unsigned* flg = (volatile unsigned*)(lds + 2 * SHM_V + 2 * SHM_K + NW * 64 * 4);
  { const unsigned myb = __any(!(l_reg >= 1e-30f && l_reg < 3e38f)) ? 1u : 0u; if (lane == 0) flg[wid] = myb; }
  __syncthreads();
  unsigned bad = 0u;
#pragma unroll
  for (int w = 0; w < NW; ++w) bad |= flg[w];
  if (bad) return true;
  if (hi == 0) li_l[r32] = l_reg; asm volatile("s_waitcnt lgkmcnt(0)" ::: "memory");
  float rli[16];
#pragma unroll
  for (int r = 0; r < 16; ++r) rli[r] = __builtin_amdgcn_rcpf(li_l[crow(r, hi)]);
  bf16_t* Ow = T.O + (size_t)(q0 + wid * QBLK) * LDO + h * 64;
#pragma unroll
  for (int r = 0; r < 16; ++r) { const int orow = crow(r, hi);
#pragma unroll
    for (int d0 = 0; d0 < 2; ++d0) { const float v = o[d0][r] * rli[r]; Ow[(size_t)orow * LDO + d0 * 32 + r32] = (bf16_t)(cvtpk(v, v) & 0xffffu); } }
  return false;
#undef SLOADK
#undef SLOADV
#undef SWRITEK
#undef SWRITEV
#undef QKT
#undef EXPH
#undef PK4
#undef FIN
#undef EXPC
}
#undef SBAR
}
#define GAS __attribute__((address_space(1)))
#define LAS __attribute__((address_space(3)))
typedef unsigned short bf16;
typedef unsigned v4u __attribute__((ext_vector_type(4)));
typedef float f32x4 __attribute__((ext_vector_type(4)));
constexpr int NWAVES = 8;
#ifndef REP_T
#define REP_T 1
#endif
#ifndef REP_H
#define REP_H 1
#endif
#ifndef REP_W
#define REP_W 1
#endif
#ifndef REP_G2
#define REP_G2 1
#endif
#ifndef REP_P0
#define REP_P0 1
#endif
#ifndef REP_P2
#define REP_P2 1
#endif
#ifndef REP_P3
#define REP_P3 1
#endif
#ifndef REP_P4
#define REP_P4 1
#endif
#ifndef REP_P7
#define REP_P7 1
#endif
constexpr int M = 16384, DM = 2048, DFF = 8192, NIN_SRC = 6432, NIN = 6656;
constexpr size_t MiB = 1u << 20;
constexpr size_t WS_WIN = 0 * MiB, WS_WUQ = 26 * MiB, WS_WUKV = 28 * MiB, WS_WA = 29 * MiB, WS_WB = 33 * MiB, WS_WOUT = 37 * MiB, WS_W1 = 45 * MiB, WS_W2 = 77 * MiB;
constexpr size_t WS_SSQ = 110 * MiB;
constexpr size_t WS_ROPEC = 111 * MiB, WS_ROPES = 112 * MiB;
constexpr size_t WS_CTL = 113 * MiB;
constexpr size_t WS_GA = 116 * MiB, WS_GB = 180 * MiB, WS_QA = 244 * MiB, WS_KA = 276 * MiB, WS_VA = 284 * MiB, WS_CQ = 292 * MiB, WS_CKV = 308 * MiB, WS_KR = 316 * MiB;
constexpr size_t WS_Q = 320 * MiB, WS_KN = 368 * MiB, WS_V = 400 * MiB, WS_OA = 432 * MiB, WS_OB = 464 * MiB;
constexpr size_t WS_H = 436 * MiB;
constexpr size_t WS_T1 = 244 * MiB, WS_MG = 308 * MiB, WS_X1B = 372 * MiB, WS_U = 116 * MiB, WS_END = 500 * MiB;
constexpr int RING_BYTES = 131072, LDS_BYTES = 147456;
#define LDS_WAIT() asm volatile("s_waitcnt lgkmcnt(0)" ::: "memory")
__device__ __forceinline__ unsigned f2bf(float f) { unsigned u = __builtin_bit_cast(unsigned, f); return (u + 0x7fffu + ((u >> 16) & 1u)) >> 16; }
__device__ __forceinline__ unsigned pk2(float lo, float hi) { return f2bf(lo) | (f2bf(hi) << 16); }
__device__ __forceinline__ float wave_sum(float v) {
#pragma unroll
    for (int o = 1; o < 64; o <<= 1) v += __shfl_xor(v, o);
    return v;
}
__device__ __forceinline__ int permI(int j) { return j < 16 ? 2 * j : 2 * (j - 16) + 1; }
__device__ __forceinline__ void p0_transpose_item(const float* W, int K, int N, bf16* WT, LAS float* scr, int kb, int n0src, int dest_base, bool perm, const float* gain, int lane) {
    const int k0 = 64 * kb;
#ifndef T_NARROW
#define T_NARROW 8
#endif
#if T_NARROW
#pragma unroll T_NARROW
    for (int i = 0; i < 32; ++i) { const int kk = 2 * i + (lane >> 5); scr[kk * 33 + (lane & 31)] = __builtin_nontemporal_load(W + (size_t)(k0 + kk) * N + n0src + (lane & 31)); }
#else
    { f32x4 v[8];
#pragma unroll
      for (int i = 0; i < 8; ++i) v[i] = *(const GAS f32x4*)(W + (size_t)(k0 + 8 * i + (lane >> 3)) * N + n0src + (lane & 7) * 4);
#pragma unroll
      for (int i = 0; i < 8; ++i) { LAS float* d = scr + (8 * i + (lane >> 3)) * 33 + (lane & 7) * 4; d[0] = v[i].x; d[1] = v[i].y; d[2] = v[i].z; d[3] = v[i].w; } }
#endif
    LDS_WAIT(); asm volatile("" ::: "memory");
    const int c = lane & 7;
    float g[8];
#pragma unroll
    for (int e = 0; e < 8; ++e) g[e] = gain ? gain[k0 + 8 * c + e] : 1.0f;
#pragma unroll
    for (int j = 0; j < 4; ++j) { const int n = (lane >> 3) + 8 * j; const LAS float* s = scr + (8 * c) * 33 + n;
        v4u o; o.x = pk2(s[0 * 33] * g[0], s[1 * 33] * g[1]); o.y = pk2(s[2 * 33] * g[2], s[3 * 33] * g[3]); o.z = pk2(s[4 * 33] * g[4], s[5 * 33] * g[5]); o.w = pk2(s[6 * 33] * g[6], s[7 * 33] * g[7]);
        const int dn = perm ? permI(n) : n;
        *(GAS v4u*)(WT + (size_t)(dest_base + dn) * K + k0 + 8 * c) = o; }
    LDS_WAIT(); asm volatile("" ::: "memory");
}
#define XB_TMO      128
#define XB_XCNT(j)  (256  + 64 * (j))
#define XB_XSUB(j)  (1280 + 64 * (j))
#define XB_XGEN(j)  (2304 + 64 * (j))
#define XB_TOP      3328
#define XB_TOPGEN   3392
#define XCD_BAR_WORDS 3456
#define XB_SPIN_CAP (1u << 18)

__device__ __forceinline__ unsigned xb_ld(unsigned* p)              { return __hip_atomic_load(p, __ATOMIC_RELAXED, __HIP_MEMORY_SCOPE_AGENT); }
__device__ __forceinline__ unsigned xb_add(unsigned* p, unsigned v) { return __hip_atomic_fetch_add(p, v, __ATOMIC_RELAXED, __HIP_MEMORY_SCOPE_AGENT); }
__device__ __forceinline__ unsigned xb_xcc_id() { return (unsigned)__builtin_amdgcn_s_getreg((3 << 11) | 20) & 0xFu; }
#define XB_SPIN(cond, bar) do { unsigned _sp = 0; while (cond) { __builtin_amdgcn_s_sleep(1); \
    if ((++_sp & 255u) == 0u) { if (xb_ld(&(bar)[XB_TMO])) break; if (_sp > XB_SPIN_CAP) { atomicAdd(&(bar)[XB_TMO], 1u); break; } } } } while (0)

struct XcdBarrier {
    unsigned* bar; unsigned x;
    volatile LAS unsigned* st;
};

__device__ __forceinline__ XcdBarrier xcd_barrier_post(unsigned* bar, volatile LAS unsigned* st) {
    XcdBarrier b; b.bar = bar; b.x = xb_xcc_id(); b.st = st;
    if (threadIdx.x == 0) (void)xb_add(&bar[XB_XCNT(b.x)], 1u);
    return b;
}
__device__ __forceinline__ void xcd_barrier_complete(unsigned* bar, unsigned x, unsigned& nloc, unsigned& nx) {
    const unsigned G = gridDim.x * gridDim.y * gridDim.z;
    unsigned sum, cnt, mine, sp = 0u;
    for (;;) {
        sum = 0u; cnt = 0u; mine = 0u;
#pragma unroll
        for (unsigned j = 0; j < 16; ++j) { const unsigned c = xb_ld(&bar[XB_XCNT(j)]); sum += c; cnt += (c > 0u) ? 1u : 0u; mine = (j == x) ? c : mine; }
        if (sum == G) break;
        __builtin_amdgcn_s_sleep(1);
        if ((++sp & 255u) == 0u) { if (xb_ld(&bar[XB_TMO])) break; if (sp > XB_SPIN_CAP) { atomicAdd(&bar[XB_TMO], 1u); break; } }
    }
    nloc = mine > 0u ? mine : 1u; nx = cnt > 0u ? cnt : 1u;
}

__device__ __forceinline__ void xcd_barrier(const XcdBarrier& b, const int wave) {
    asm volatile("s_waitcnt vmcnt(0)" ::: "memory");
    __syncthreads();
    if (wave == 0 && lane_now() == 0) {
        unsigned* bar = b.bar;
        __builtin_amdgcn_s_waitcnt(0);
        unsigned nloc = b.st[0], nx = b.st[1];
        if (nloc == 0u) { xcd_barrier_complete(bar, b.x, nloc, nx); b.st[0] = nloc; b.st[1] = nx; }
        const unsigned old = xb_add(&bar[XB_XSUB(b.x)], 1u);
        const unsigned gen = old / nloc;
        if (old + 1u == (gen + 1u) * nloc) {
            __builtin_amdgcn_fence(__ATOMIC_RELEASE, "agent");
            asm volatile("s_waitcnt vmcnt(0)" ::: "memory");
            const unsigned og = xb_add(&bar[XB_TOP], 1u);
            const unsigned tg = og / nx;
            if (og + 1u == (tg + 1u) * nx) xb_add(&bar[XB_TOPGEN], 1u);
            else XB_SPIN(xb_ld(&bar[XB_TOPGEN]) == tg, bar);
            __builtin_amdgcn_fence(__ATOMIC_ACQUIRE, "agent");
            xb_add(&bar[XB_XGEN(b.x)], 1u);
            asm volatile("s_waitcnt vmcnt(0)" ::: "memory");
        } else {
            XB_SPIN(xb_ld(&bar[XB_XGEN(b.x)]) == gen, bar);
            __builtin_amdgcn_fence(__ATOMIC_ACQUIRE, "agent");
            asm volatile("s_waitcnt vmcnt(0)" ::: "memory");
        }
    }
    __syncthreads();
}
__device__ __forceinline__ void grid_bar(unsigned* ctr, unsigned target, int wave) {
    asm volatile("s_waitcnt vmcnt(0) lgkmcnt(0)" ::: "memory");
    __syncthreads();
    if (wave == 0) {
        __builtin_amdgcn_fence(__ATOMIC_RELEASE, "agent");
        if (lane_now() == 0) {
            __hip_atomic_fetch_add(ctr, 1u, __ATOMIC_RELAXED, __HIP_MEMORY_SCOPE_AGENT);
            while (__hip_atomic_load(ctr, __ATOMIC_RELAXED, __HIP_MEMORY_SCOPE_AGENT) < target) __builtin_amdgcn_s_sleep(2);
        }
        __builtin_amdgcn_fence(__ATOMIC_ACQUIRE, "agent");
        asm volatile("s_waitcnt vmcnt(0)" ::: "memory");
    }
    __syncthreads();
}
struct Args { const void* in[17]; float* out; unsigned char* ws; };
__global__ void __launch_bounds__(NWAVES * 64, 2) mega_fwd(Args args) {
    extern __shared__ __attribute__((aligned(16))) unsigned char lds[];
    { cg::grid_group grid = cg::this_grid(); grid.sync(); }
    LAS unsigned char* ldsl = (LAS unsigned char*)lds;
    const int wave = __builtin_amdgcn_readfirstlane((int)threadIdx.x >> 6);
    const int G = gridDim.x, bx = blockIdx.x;
    const int vcu = (G % 8 == 0) ? (bx % 8) * (G / 8) + bx / 8 : bx;
    unsigned char* ws = args.ws;
    const float* x = (const float*)args.in[0]; const int* pos = (const int*)args.in[1]; const float* g_attn = (const float*)args.in[2]; const float* w_in = (const float*)args.in[3];
    const float* a_sink = (const float*)args.in[4]; const float* g_q = (const float*)args.in[5]; const float* g_kv = (const float*)args.in[6];
    const float* w_uq = (const float*)args.in[7]; const float* w_uk = (const float*)args.in[8]; const float* w_uv = (const float*)args.in[9];
    const float* w_a = (const float*)args.in[10]; const float* w_b = (const float*)args.in[11]; const float* w_out = (const float*)args.in[12];
    const float* g_mlp = (const float*)args.in[13]; const float* w_1 = (const float*)args.in[14]; const float* w_2 = (const float*)args.in[15]; const float* g_fin = (const float*)args.in[16];
    float* out = args.out;
#define WSB() ({ size_t z_ = 0; asm volatile("" : "+s"(z_)); ws + z_; })
#define DEFPTRS unsigned char* wsb = WSB(); \
    bf16 *Win_t = (bf16*)(wsb + WS_WIN), *Wuq_t = (bf16*)(wsb + WS_WUQ), *Wukv_t = (bf16*)(wsb + WS_WUKV), *Wa_t = (bf16*)(wsb + WS_WA), *Wb_t = (bf16*)(wsb + WS_WB), *Wout_t = (bf16*)(wsb + WS_WOUT), *W1_t = (bf16*)(wsb + WS_W1), *W2_t = (bf16*)(wsb + WS_W2); \
    float* ssq_q = (float*)(wsb + WS_SSQ); float* ssq_kv = ssq_q + M; float* ssq_x1 = ssq_q + 2 * M; float* ssq_x2 = ssq_q + 3 * M; unsigned* knmax = (unsigned*)(ssq_q + 4 * M); \
    float* ropec = (float*)(wsb + WS_ROPEC); float* ropes = (float*)(wsb + WS_ROPES); \
    bf16 *GA = (bf16*)(wsb + WS_GA), *GB = (bf16*)(wsb + WS_GB), *QA = (bf16*)(wsb + WS_QA), *KA = (bf16*)(wsb + WS_KA), *VA = (bf16*)(wsb + WS_VA), *CQ = (bf16*)(wsb + WS_CQ), *CKV = (bf16*)(wsb + WS_CKV), *KR = (bf16*)(wsb + WS_KR); \
    bf16 *Qb = (bf16*)(wsb + WS_Q), *KN = (bf16*)(wsb + WS_KN), *Vb = (bf16*)(wsb + WS_V), *OA = (bf16*)(wsb + WS_OA), *OB = (bf16*)(wsb + WS_OB), *Hb = (bf16*)(wsb + WS_H); \
    bf16 *T1 = (bf16*)(wsb + WS_T1), *MG = (bf16*)(wsb + WS_MG), *X1B = (bf16*)(wsb + WS_X1B), *Ub = (bf16*)(wsb + WS_U); \
    (void)Win_t; (void)Wuq_t; (void)Wukv_t; (void)Wa_t; (void)Wb_t; (void)Wout_t; (void)W1_t; (void)W2_t; (void)ssq_kv; (void)ssq_x1; (void)ssq_x2; (void)knmax; (void)ropec; (void)ropes; \
    (void)GA; (void)GB; (void)QA; (void)KA; (void)VA; (void)CQ; (void)CKV; (void)KR; (void)Qb; (void)KN; (void)Vb; (void)OA; (void)OB; (void)Hb; (void)T1; (void)MG; (void)X1B; (void)Ub;
    const int gw = vcu * NWAVES + wave, NGW = G * NWAVES, NGT = NGW * 64;
    unsigned bar_target = 0u;
#ifndef REP_BAR
#define REP_BAR 1
#endif
#ifndef USE_XBAR
#define USE_XBAR 1
#endif
#if USE_XBAR
    { volatile LAS unsigned* st_ = (volatile LAS unsigned*)(ldsl + RING_BYTES + 64); if (threadIdx.x < 2) st_[threadIdx.x] = 0u; }
    __syncthreads();
    const XcdBarrier xbar = xcd_barrier_post((unsigned*)(ws + WS_CTL), (volatile LAS unsigned*)(ldsl + RING_BYTES + 64));
#define GRID_BAR() do { for (int rb_ = 0; rb_ < REP_BAR; ++rb_) xcd_barrier(xbar, wave); } while (0)
#else
#define GRID_BAR() do { for (int rb_ = 0; rb_ < REP_BAR; ++rb_) { bar_target += (unsigned)G; grid_bar((unsigned*)(ws + WS_CTL), bar_target, wave); } } while (0)
#endif

    for (int rep = 0; rep < REP_P0; ++rep) { DEFPTRS
        const int lane = lane_now(), gt = gw * 64 + lane;
        for (int i = gt; i < 4 * M + 64; i += NGT) ssq_q[i] = 0.f;
#ifndef REP_R
#define REP_R 1
#endif
        const float inv = (float)exp2(-(double)(gt & 15) * (13.287712379549449 / 16.0));
        for (int rr_ = 0; rr_ < REP_R; ++rr_)
        for (int i = gt; i < M * 16; i += NGT) { const int r = i >> 4;
            const float ang = (float)pos[r] * inv;
            double t = (double)ang * 0.15915494309189535; t -= rint(t); const float fr = (float)t;
            ropec[i] = __builtin_amdgcn_cosf(fr); ropes[i] = __builtin_amdgcn_sinf(fr); }
        for (int i = gt; i < 224 * 2048 / 8; i += NGT) *(GAS v4u*)(Win_t + (size_t)2336 * 2048 + (size_t)i * 8) = (v4u){0u, 0u, 0u, 0u};
        LAS float* scr = (LAS float*)(ldsl + wave * 16384);
        constexpr int I_IN = 32 * 201, I_UQ = 8 * 48, I_UK = 4 * 32, I_A = 16 * 64, I_OUT = 32 * 64, I_1 = 32 * 256, I_2 = 128 * 64;
        constexpr int NITEMS = I_IN + I_UQ + 2 * I_UK + 2 * I_A + I_OUT + I_1 + I_2;
        for (int rt = 0; rt < REP_T; ++rt)
        for (int it = gw; it < NITEMS; it += NGW) {
            int r = it;
            if (r < I_IN) { const int kb = r / 201, nb = r % 201; const int db = nb < 72 ? 32 * nb : (nb == 72 ? 2304 : 32 * nb + 224);
                p0_transpose_item(w_in, 2048, NIN_SRC, Win_t, scr, kb, 32 * nb, db, nb == 72, nullptr, lane); continue; } r -= I_IN;
            if (r < I_UQ) { const int kb = r / 48, nb = r % 48, hh = nb / 3, part = nb % 3; const int db = part < 2 ? hh * 64 + part * 32 : 1024 + hh * 32;
                p0_transpose_item(w_uq, 512, 1536, Wuq_t, scr, kb, 32 * nb, db, part == 2, g_q, lane); continue; } r -= I_UQ;
            if (r < I_UK) { p0_transpose_item(w_uk, 256, 1024, Wukv_t, scr, r / 32, 32 * (r % 32), 32 * (r % 32), false, g_kv, lane); continue; } r -= I_UK;
            if (r < I_UK) { p0_transpose_item(w_uv, 256, 1024, Wukv_t, scr, r / 32, 32 * (r % 32), 1024 + 32 * (r % 32), false, g_kv, lane); continue; } r -= I_UK;
            if (r < I_A) { p0_transpose_item(w_a, 1024, 2048, Wa_t, scr, r / 64, 32 * (r % 64), 32 * (r % 64), false, nullptr, lane); continue; } r -= I_A;
            if (r < I_A) { p0_transpose_item(w_b, 1024, 2048, Wb_t, scr, r / 64, 32 * (r % 64), 32 * (r % 64), false, nullptr, lane); continue; } r -= I_A;
            if (r < I_OUT) { p0_transpose_item(w_out, 2048, 2048, Wout_t, scr, r / 64, 32 * (r % 64), 32 * (r % 64), false, nullptr, lane); continue; } r -= I_OUT;
            if (r < I_1) { p0_transpose_item(w_1, 2048, 8192, W1_t, scr, r / 256, 32 * (r % 256), 32 * (r % 256), false, g_mlp, lane); continue; } r -= I_1;
            p0_transpose_item(w_2, 8192, 2048, W2_t, scr, r / 64, 32 * (r % 64), 32 * (r % 64), false, nullptr, lane);
        }
        for (int rh = 0; rh < REP_H; ++rh)
        for (int m = gw; m < M; m += NGW) {
            const GAS f32x4* xr = (const GAS f32x4*)(x + (size_t)m * DM) + lane; f32x4 v[8]; float s = 0.f;
#pragma unroll
            for (int j = 0; j < 8; ++j) { v[j] = __builtin_nontemporal_load(xr + 64 * j); s += (v[j].x * v[j].x + v[j].y * v[j].y) + (v[j].z * v[j].z + v[j].w * v[j].w); }
            const float rstd = 1.0f / sqrtf(wave_sum(s) * (1.0f / DM) + 1e-6f);
            GAS unsigned long long* o8 = (GAS unsigned long long*)(Hb + (size_t)m * DM) + lane;
#pragma unroll
            for (int j = 0; j < 8; ++j) { const f32x4 gg = *((const GAS f32x4*)g_attn + lane + 64 * j); const f32x4 y = v[j] * rstd * gg;
                o8[64 * j] = (unsigned long long)pk2(y.x, y.y) | ((unsigned long long)pk2(y.z, y.w) << 32); }
        }
    }
    GRID_BAR();
    { DEFPTRS
        pg8::Gemm g{Hb, Win_t, M, NIN, DM}; pg8::StaticOrder S; S.init(M, NIN, G, bx);
        pg8::EpiRow<pg8::F1> E{{QA, KA, VA, CQ, CKV, KR, GA, GB, ssq_q, ssq_kv, ropec, ropes, knmax}};
        pg8::gemm_phase<pg8::EpiRow<pg8::F1>, pg8::StaticOrder, true, true>(ldsl, g, S, E, wave);
    }
    GRID_BAR();
    for (int rep = 0; rep < REP_P2; ++rep) { DEFPTRS
        { pg8::Gemm g{CQ, Wuq_t, M, 1536, 512}; pg8::StaticOrder S; S.init(M, 1536, G, bx);
          pg8::EpiRow<pg8::F2a> E{{Qb, ssq_q, ropec, ropes}};
          pg8::gemm_phase<pg8::EpiRow<pg8::F2a>, pg8::StaticOrder, true, true>(ldsl, g, S, E, wave); }
        { pg8::Gemm g{CKV, Wukv_t, M, 2048, 256}; pg8::StaticOrder S; S.init(M, 2048, G, bx);
          pg8::EpiRow<pg8::F2b> E{{KN, Vb, ssq_kv, knmax}};
          pg8::gemm_phase<pg8::EpiRow<pg8::F2b>, pg8::StaticOrder, true, true>(ldsl, g, S, E, wave); }
        const att::Tensors TA{QA, KA, nullptr, VA, OA, pos, a_sink};
        for (int rw = 0; rw < REP_W; ++rw)
        for (int u = vcu; u < 1024; u += G) att::unit<1>(TA, u >> 6, u & 63, (char*)lds, wave);
    }
    GRID_BAR();
    for (int rep = 0; rep < REP_P3; ++rep) { DEFPTRS
        const att::Tensors TB{Qb, KN, KR, Vb, OB, pos, a_sink};
        for (int u = vcu; u < 1024; u += G) { int uu = (u % G) * (1024 / G) + u / G;
#ifndef P3_ONE_HEAD_PER_XCD
#define P3_ONE_HEAD_PER_XCD 1
#endif
            if (P3_ONE_HEAD_PER_XCD && G == 256) { const int i_ = u / G, x_ = vcu >> 5, j_ = vcu & 31; uu = ((2 * x_ + (i_ >> 1)) << 6) | (j_ * 2 + (i_ & 1)); }
#ifdef FORCE_SLOW
            att::unit<0>(TB, uu >> 6, uu & 63, (char*)lds, wave); }
#else
            if (att::unit_fast(TB, knmax, uu >> 6, uu & 63, (char*)lds, wave)) att::unit<0>(TB, uu >> 6, uu & 63, (char*)lds, wave); }
#endif
    }
    GRID_BAR();
    for (int rep = 0; rep < REP_P4; ++rep) { DEFPTRS
        { pg8::Gemm g{OA, Wa_t, M, DM, 1024}; pg8::StaticOrder S; S.init(M, DM, G, bx);
          pg8::EpiRow<pg8::F4a> E{{GA, T1}};
          pg8::gemm_phase<pg8::EpiRow<pg8::F4a>, pg8::StaticOrder, true, true>(ldsl, g, S, E, wave); }
        __syncthreads();
        { pg8::Gemm g{OB, Wb_t, M, DM, 1024}; pg8::StaticOrder S; S.init(M, DM, G, bx);
          pg8::EpiRow<pg8::F4b> E{{GB, T1, MG}};
          pg8::gemm_phase<pg8::EpiRow<pg8::F4b>, pg8::StaticOrder, true, true>(ldsl, g, S, E, wave); }
    }
    GRID_BAR();
    { DEFPTRS
        pg8::Gemm g{MG, Wout_t, M, DM, DM}; pg8::StaticOrder S; S.init(M, DM, G, bx);
        pg8::EpiRow<pg8::FRes<true>> E{{x, out, X1B, ssq_x1}};
        pg8::gemm_phase<pg8::EpiRow<pg8::FRes<true>>, pg8::StaticOrder, true, true>(ldsl, g, S, E, wave);
    }
    GRID_BAR();
    for (int rep = 0; rep < REP_P7; ++rep) { DEFPTRS
        pg8::Gemm g{X1B, W1_t, M, DFF, DM}; pg8::StaticOrder S; S.init(M, DFF, G, bx);
        pg8::EpiRow<pg8::F7> E{{Ub, ssq_x1}};
        pg8::gemm_phase<pg8::EpiRow<pg8::F7>, pg8::StaticOrder, true, true>(ldsl, g, S, E, wave);
    }
    GRID_BAR();
    { DEFPTRS
        pg8::Gemm g{Ub, W2_t, M, DM, DFF}; pg8::StaticOrder S; S.init(M, DM, G, bx);
        pg8::EpiRow<pg8::FRes<false>> E{{out, out, nullptr, ssq_x2}};
        pg8::gemm_phase<pg8::EpiRow<pg8::FRes<false>>, pg8::StaticOrder, true, true>(ldsl, g, S, E, wave);
    }
    GRID_BAR();
    DEFPTRS
    const int lane9 = lane_now();
    for (int m = gw; m < M; m += NGW) {
        GAS f32x4* xr = (GAS f32x4*)(out + (size_t)m * DM) + lane9;
        const float rstd = 1.0f / sqrtf(ssq_x2[m] * (1.0f / DM) + 1e-6f);
#pragma unroll
        for (int j = 0; j < 8; ++j) { const f32x4 gg = *((const GAS f32x4*)g_fin + lane9 + 64 * j); const f32x4 xv = __builtin_nontemporal_load(xr + 64 * j); __builtin_nontemporal_store(xv * rstd * gg, xr + 64 * j); }
    }
}

extern "C" void kernel_launch(void* const* d_in, const int* in_sizes, int n_in, void* d_out, int out_size, void* d_ws, size_t ws_size, hipStream_t stream) {
    static int grid = 0;
    if (grid == 0) {
        if (n_in != 17 || in_sizes[0] != M * DM || out_size != M * DM || ws_size < WS_END) { fprintf(stderr, "kernel_launch: unexpected shapes (n_in %d, in0 %d, out %d, ws %zu)\n", n_in, n_in > 0 ? in_sizes[0] : -1, out_size, ws_size); grid = -1; return; }
        int dev = 0, cus = 0, per_cu = 0;
        if (hipGetDevice(&dev) != hipSuccess || hipDeviceGetAttribute(&cus, hipDeviceAttributeMultiprocessorCount, dev) != hipSuccess) { grid = -1; return; }
        if (hipFuncSetAttribute((const void*)mega_fwd, hipFuncAttributeMaxDynamicSharedMemorySize, LDS_BYTES) != hipSuccess) { fprintf(stderr, "kernel_launch: hipFuncSetAttribute failed\n"); grid = -1; return; }
        if (hipOccupancyMaxActiveBlocksPerMultiprocessor(&per_cu, (const void*)mega_fwd, NWAVES * 64, LDS_BYTES) != hipSuccess || per_cu < 1) { fprintf(stderr, "kernel_launch: occupancy query says %d\n", per_cu); per_cu = 1; }
        (void)hipGetLastError();
        grid = cus * per_cu;
    }
    if (grid < 0) return;
    if (hipMemsetAsync((char*)d_ws + WS_CTL, 0, 16384, stream) != hipSuccess) { fprintf(stderr, "kernel_launch: memset failed\n"); return; }
    Args a{};
    for (int i = 0; i < 17; ++i) a.in[i] = d_in[i];
    a.out = (float*)d_out; a.ws = (unsigned char*)d_ws;
    void* kargs[] = {&a};
    const hipError_t e = hipLaunchCooperativeKernel((const void*)mega_fwd, dim3(grid), dim3(NWAVES * 64), kargs, LDS_BYTES, stream);
    if (e != hipSuccess) fprintf(stderr, "kernel_launch: cooperative launch failed: %s (grid %d)\n", hipGetErrorString(e), grid);
}
```

```cpp
#include <hip/hip_runtime.h>
#include <hip/hip_cooperative_groups.h>
#include <cstdio>
#include <cstdint>
namespace cg = cooperative_groups;
__device__ __forceinline__ int lane_now() { int l; asm volatile("v_mbcnt_lo_u32_b32 %0, -1, 0\n\tv_mbcnt_hi_u32_b32 %0, -1, %0" : "=v"(l)); return l; }
namespace pg8 {
#define PG8_LAS __attribute__((address_space(3)))
typedef unsigned short bf16_t;
typedef short bf16x8 __attribute__((ext_vector_type(8)));
typedef float f32x4 __attribute__((ext_vector_type(4)));
typedef unsigned u32x4 __attribute__((ext_vector_type(4)));
constexpr int BM = 256, BK = 64, HALF = 128, HTB = HALF * BK * 2  , STAGE_BYTES = 8 * HTB, NXCD = 8, WGM = 8;

__host__ __device__ __forceinline__ int lds_byte(int r, int c) { const int st = (r >> 4) * 2 + (c >> 5), rr = r & 15, cc = c & 31, ob = rr * 64 + cc * 2; return st * 1024 + (ob ^ (((ob >> 9) & 1) << 5)); }
__host__ __device__ __forceinline__ void stage_rc(int b, int& R, int& C) { const int st = b / 1024, sb = b % 1024, swz = sb ^ (((sb >> 9) & 1) << 5); R = (st >> 1) * 16 + swz / 64; C = (st & 1) * 32 + (swz % 64) / 2; }
__host__ __device__ __forceinline__ int perm32(int rho) { const int n = rho >> 4, i = rho & 15; return 8 * (i >> 2) + 4 * n + (i & 3); }

struct Unit { int pm, pn; };
struct Gemm { const bf16_t* A; const bf16_t* Bt; int M, N, K; };

struct StaticOrder {
    int nM, nN, nwg, G, c;
    __host__ __device__ void init(int M, int N, int G_, int c_) { nM = M / BM; nN = N / BM; nwg = nM * nN; G = G_; c = c_; }
    __host__ __device__ bool next(int i, Unit& u) const {
        const long L = (long)i * G + c; if (L >= nwg) return false;
        int wgid = (int)L; { const int q = nwg / NXCD, r = nwg % NXCD, xcd = wgid % NXCD, off = wgid / NXCD; wgid = (xcd < r ? xcd * (q + 1) : r * (q + 1) + (xcd - r) * q) + off; }
        const int nig = WGM * nN, gid = wgid / nig, fm = gid * WGM, gsz = (nM - fm) < WGM ? (nM - fm) : WGM;
        u.pm = fm + ((wgid % nig) % gsz); u.pn = (wgid % nig) / gsz; return true;
    }
    __device__ __forceinline__ void a_ready(const Unit&) const {}
    __device__ __forceinline__ void done(const Unit&) const {}
};

__device__ __forceinline__ unsigned cvt_pk_bf16(float lo, float hi) { unsigned r; asm volatile("v_cvt_pk_bf16_f32 %0, %1, %2" : "=v"(r) : "v"(lo), "v"(hi)); return r; }
typedef float f32x2 __attribute__((ext_vector_type(2)));
__device__ __forceinline__ u32x4 pack8(f32x4 a, f32x4 b) { u32x4 w; w.x = cvt_pk_bf16(a[0], a[1]); w.y = cvt_pk_bf16(a[2], a[3]); w.z = cvt_pk_bf16(b[0], b[1]); w.w = cvt_pk_bf16(b[2], b[3]); return w; }
__device__ __forceinline__ void st8(bf16_t* p, f32x4 a, f32x4 b) { *(u32x4*)p = pack8(a, b); }
__device__ __forceinline__ void ld8f(const bf16_t* p, f32x4& a, f32x4& b) {
    const u32x4 w = *(const u32x4*)p;
    a[0] = __uint_as_float(w.x << 16); a[1] = __uint_as_float(w.x & 0xffff0000u); a[2] = __uint_as_float(w.y << 16); a[3] = __uint_as_float(w.y & 0xffff0000u);
    b[0] = __uint_as_float(w.z << 16); b[1] = __uint_as_float(w.z & 0xffff0000u); b[2] = __uint_as_float(w.w << 16); b[3] = __uint_as_float(w.w & 0xffff0000u);
}
__device__ __forceinline__ void up8(const u32x4 w, f32x4& a, f32x4& b) {
    a[0] = __uint_as_float(w.x << 16); a[1] = __uint_as_float(w.x & 0xffff0000u); a[2] = __uint_as_float(w.y << 16); a[3] = __uint_as_float(w.y & 0xffff0000u);
    b[0] = __uint_as_float(w.z << 16); b[1] = __uint_as_float(w.z & 0xffff0000u); b[2] = __uint_as_float(w.w << 16); b[3] = __uint_as_float(w.w & 0xffff0000u);
}
struct NoPre {};
__device__ __forceinline__ float sq4(f32x4 v) { return (v[0] * v[0] + v[1] * v[1]) + (v[2] * v[2] + v[3] * v[3]); }
__device__ __forceinline__ float rowred(float s) { s += __shfl_xor(s, 16); s += __shfl_xor(s, 32); return s; }
__device__ __forceinline__ void rope8(f32x4& a0, f32x4& a1, const float* c, const float* s) {
    const f32x4 cv = *(const f32x4*)c, sv = *(const f32x4*)s; float x1, x2;
    x1 = a0[0]; x2 = a0[1]; a0[0] = x1 * cv[0] - x2 * sv[0]; a0[1] = x2 * cv[0] + x1 * sv[0];
    x1 = a0[2]; x2 = a0[3]; a0[2] = x1 * cv[1] - x2 * sv[1]; a0[3] = x2 * cv[1] + x1 * sv[1];
    x1 = a1[0]; x2 = a1[1]; a1[0] = x1 * cv[2] - x2 * sv[2]; a1[1] = x2 * cv[2] + x1 * sv[2];
    x1 = a1[2]; x2 = a1[3]; a1[2] = x1 * cv[3] - x2 * sv[3]; a1[3] = x2 * cv[3] + x1 * sv[3];
}
__device__ __forceinline__ f32x4 sigm4(f32x4 v) { f32x4 r;
#pragma unroll
    for (int i = 0; i < 4; ++i) r[i] = __builtin_amdgcn_rcpf(1.0f + __builtin_amdgcn_exp2f(-1.4426950408889634f * v[i]));
    return r; }
constexpr float RMS_EPS = 1e-6f;
__device__ __forceinline__ float frmax(float v) { v = fmaxf(v, __shfl_xor(v, 1)); v = fmaxf(v, __shfl_xor(v, 2)); v = fmaxf(v, __shfl_xor(v, 4)); v = fmaxf(v, __shfl_xor(v, 8)); return v; }
#define NOFIN __device__ __forceinline__ void finish(int, int, float, float) const {}

template <class F> struct EpiRow {
    static constexpr bool PERM = true, AFTER_DRAIN = false;
    F f;
    __device__ __forceinline__ void operator()(const f32x4 (&acc)[2][2][4][2], const Unit& u, int wr, int wc, int fr, int fq) const {
        const int lc = wc * 32 + 8 * fq; float s0 = 0.f, s1 = 0.f;
#pragma unroll
        for (int ai = 0; ai < 2; ++ai) {
            typename F::Pre pre[4];
#pragma unroll
            for (int m = 0; m < 4; ++m) pre[m] = f.pre(u.pm * BM + ai * HALF + wr * 64 + m * 16 + fr, lc, u.pn);
#pragma unroll
            for (int m = 0; m < 4; ++m) {
                const int row = u.pm * BM + ai * HALF + wr * 64 + m * 16 + fr;
                f.row(row, lc, u.pn, acc[ai][0][m][0], acc[ai][0][m][1], acc[ai][1][m][0], acc[ai][1][m][1], fq, s0, s1, pre[m]);
            }
        }
        f.finish(u.pn, wc, s0, s1);
    }
};
struct F1 {
    typedef NoPre Pre; __device__ __forceinline__ Pre pre(int, int, int) const { return Pre{}; }
    bf16_t *QA, *KA, *VA, *CQ, *CKV, *KR, *GA, *GB; float *ssq_q, *ssq_kv; const float *rc, *rs; unsigned* knmax;
    __device__ __forceinline__ void finish(int pn, int wc, float s0, float s1) const { if (pn == 9 && wc == 0) { const float m = frmax(s0); if (lane_now() == 0) atomicMax(knmax + 32, __float_as_uint(m)); } }
    __device__ __forceinline__ void row(int row, int lc, int pn, f32x4 a0, f32x4 a1, f32x4 b0, f32x4 b1, int fq, float& s0, float& s1, const Pre& P) const {
        if (pn < 4) { bf16_t* p = QA + (size_t)row * 1024 + pn * 256 + lc; st8(p, a0, a1); st8(p + 128, b0, b1); }
        else if (pn == 4) { bf16_t* p = KA + (size_t)row * 256 + lc; st8(p, a0, a1); st8(p + 128, b0, b1); }
        else if (pn == 5) { bf16_t* p = VA + (size_t)row * 256 + lc; st8(p, a0, a1); st8(p + 128, b0, b1); }
        else if (pn < 8) { bf16_t* p = CQ + (size_t)row * 512 + (pn - 6) * 256 + lc; st8(p, a0, a1); st8(p + 128, b0, b1);
            const float s = rowred((sq4(a0) + sq4(a1)) + (sq4(b0) + sq4(b1))); if (fq == 0) unsafeAtomicAdd(ssq_q + row, s); }
        else if (pn == 8) { bf16_t* p = CKV + (size_t)row * 256 + lc; st8(p, a0, a1); st8(p + 128, b0, b1);
            const float s = rowred((sq4(a0) + sq4(a1)) + (sq4(b0) + sq4(b1))); if (fq == 0) unsafeAtomicAdd(ssq_kv + row, s); }
        else if (pn == 9) { if (lc < 32) { rope8(a0, a1, rc + (size_t)row * 16 + 4 * fq, rs + (size_t)row * 16 + 4 * fq); st8(KR + (size_t)row * 32 + lc, a0, a1); s0 = fmaxf(s0, rowred(sq4(a0) + sq4(a1))); } }
        else if (pn < 18) { bf16_t* p = GA + (size_t)row * 2048 + (pn - 10) * 256 + lc; st8(p, sigm4(a0), sigm4(a1)); st8(p + 128, sigm4(b0), sigm4(b1)); }
        else { bf16_t* p = GB + (size_t)row * 2048 + (pn - 18) * 256 + lc; st8(p, sigm4(a0), sigm4(a1)); st8(p + 128, sigm4(b0), sigm4(b1)); }
    }
};
struct F2a {
    bf16_t* Q; const float* ssq_q; const float *rc, *rs; NOFIN
    struct Pre { float q; }; __device__ __forceinline__ Pre pre(int row, int, int) const { return Pre{ssq_q[row]}; }
    __device__ __forceinline__ void row(int row, int lc, int pn, f32x4 a0, f32x4 a1, f32x4 b0, f32x4 b1, int fq, float& s0, float& s1, const Pre& P) const {
        const float rstd = __builtin_amdgcn_rsqf(P.q * (1.0f / 512.0f) + RMS_EPS) * (0.10206207261596575f * 1.4426950408889634f);
        a0 *= rstd; a1 *= rstd; b0 *= rstd; b1 *= rstd;
        if (pn < 4) { bf16_t* p = Q + (size_t)row * 1536 + pn * 256 + lc; st8(p, a0, a1); st8(p + 128, b0, b1); }
        else { const float* c = rc + (size_t)row * 16 + 4 * fq; const float* s = rs + (size_t)row * 16 + 4 * fq; rope8(a0, a1, c, s); rope8(b0, b1, c, s);
            bf16_t* p = Q + (size_t)row * 1536 + 1024 + (pn - 4) * 256 + lc; st8(p, a0, a1); st8(p + 128, b0, b1); }
    }
};
struct F2b {
    struct Pre { float q; }; __device__ __forceinline__ Pre pre(int row, int, int) const { return Pre{ssq_kv[row]}; }
    bf16_t *KN, *V; const float* ssq_kv; unsigned* knmax;
    __device__ __forceinline__ void finish(int pn, int wc, float s0, float s1) const { if (pn < 4) { const float m0 = frmax(s0), m1 = frmax(s1);
        if (lane_now() == 0) { atomicMax(knmax + (pn * 4 + (wc >> 1)) * 2 + (wc & 1), __float_as_uint(m0)); atomicMax(knmax + (pn * 4 + 2 + (wc >> 1)) * 2 + (wc & 1), __float_as_uint(m1)); } } }
    __device__ __forceinline__ void row(int row, int lc, int pn, f32x4 a0, f32x4 a1, f32x4 b0, f32x4 b1, int fq, float& s0, float& s1, const Pre& P) const {
        const float rstd = __builtin_amdgcn_rsqf(P.q * (1.0f / 256.0f) + RMS_EPS);
        a0 *= rstd; a1 *= rstd; b0 *= rstd; b1 *= rstd;
        bf16_t* p = (pn < 4 ? KN + pn * 256 : V + (pn - 4) * 256) + (size_t)row * 1024 + lc; st8(p, a0, a1); st8(p + 128, b0, b1);
        if (pn < 4) { s0 = fmaxf(s0, rowred(sq4(a0) + sq4(a1))); s1 = fmaxf(s1, rowred(sq4(b0) + sq4(b1))); }
    }
};
struct F4a {
    const bf16_t* G; bf16_t* T1; NOFIN
    struct Pre { u32x4 g0, g1; }; __device__ __forceinline__ Pre pre(int row, int lc, int pn) const { const size_t off = (size_t)row * 2048 + pn * 256 + lc; return Pre{__builtin_nontemporal_load((const u32x4*)(G + off)), __builtin_nontemporal_load((const u32x4*)(G + off + 128))}; }
    __device__ __forceinline__ void row(int row, int lc, int pn, f32x4 a0, f32x4 a1, f32x4 b0, f32x4 b1, int fq, float& s0, float& s1, const Pre& P) const {
        const size_t off = (size_t)row * 2048 + pn * 256 + lc; f32x4 g0, g1, g2, g3; up8(P.g0, g0, g1); up8(P.g1, g2, g3);
        st8(T1 + off, a0 * g0, a1 * g1); st8(T1 + off + 128, b0 * g2, b1 * g3);
    }
};
struct F4b {
    const bf16_t *G, *T1; bf16_t* MG; NOFIN
    struct Pre { u32x4 g0, g1, t0, t1; }; __device__ __forceinline__ Pre pre(int row, int lc, int pn) const { const size_t off = (size_t)row * 2048 + pn * 256 + lc; return Pre{__builtin_nontemporal_load((const u32x4*)(G + off)), __builtin_nontemporal_load((const u32x4*)(G + off + 128)), *(const u32x4*)(T1 + off), *(const u32x4*)(T1 + off + 128)}; }
    __device__ __forceinline__ void row(int row, int lc, int pn, f32x4 a0, f32x4 a1, f32x4 b0, f32x4 b1, int fq, float& s0, float& s1, const Pre& P) const {
        const size_t off = (size_t)row * 2048 + pn * 256 + lc; f32x4 g0, g1, g2, g3, t0, t1, t2, t3; up8(P.g0, g0, g1); up8(P.g1, g2, g3); up8(P.t0, t0, t1); up8(P.t1, t2, t3);
        st8(MG + off, t0 + a0 * g0, t1 + a1 * g1); st8(MG + off + 128, t2 + b0 * g2, t3 + b1 * g3);
    }
};
template <bool WITH_BF16> struct FRes {
    const float* X; float* O; bf16_t* XB; float* ssq; NOFIN
    struct Pre { f32x4 x0, x1, x2, x3; }; __device__ __forceinline__ Pre pre(int row, int lc, int pn) const { const size_t off = (size_t)row * 2048 + pn * 256 + lc; return Pre{__builtin_nontemporal_load((const f32x4*)(X + off)), __builtin_nontemporal_load((const f32x4*)(X + off + 4)), __builtin_nontemporal_load((const f32x4*)(X + off + 128)), __builtin_nontemporal_load((const f32x4*)(X + off + 132))}; }
    __device__ __forceinline__ void row(int row, int lc, int pn, f32x4 a0, f32x4 a1, f32x4 b0, f32x4 b1, int fq, float& s0, float& s1, const Pre& P) const {
        const size_t off = (size_t)row * 2048 + pn * 256 + lc;
        a0 += P.x0; a1 += P.x1; b0 += P.x2; b1 += P.x3;
        *(f32x4*)(O + off) = a0; *(f32x4*)(O + off + 4) = a1; *(f32x4*)(O + off + 128) = b0; *(f32x4*)(O + off + 132) = b1;
        if (WITH_BF16) { st8(XB + off, a0, a1); st8(XB + off + 128, b0, b1); }
        const float s = rowred((sq4(a0) + sq4(a1)) + (sq4(b0) + sq4(b1))); if (fq == 0) unsafeAtomicAdd(ssq + row, s);
    }
};
struct F7 {
    bf16_t* U; const float* ssq; NOFIN
    struct Pre { float q; }; __device__ __forceinline__ Pre pre(int row, int, int) const { return Pre{ssq[row]}; }
    __device__ __forceinline__ void row(int row, int lc, int pn, f32x4 a0, f32x4 a1, f32x4 b0, f32x4 b1, int fq, float& s0, float& s1, const Pre& P) const {
        const float rstd = __builtin_amdgcn_rsqf(P.q * (1.0f / 2048.0f) + RMS_EPS);
        const f32x4 z = {0.f, 0.f, 0.f, 0.f};
        a0 = __builtin_elementwise_max(a0 * rstd, z); a1 = __builtin_elementwise_max(a1 * rstd, z); b0 = __builtin_elementwise_max(b0 * rstd, z); b1 = __builtin_elementwise_max(b1 * rstd, z);
        bf16_t* p = U + (size_t)row * 8192 + pn * 256 + lc; st8(p, a0 * a0, a1 * a1); st8(p + 128, b0 * b0, b1 * b1);
    }
};
template <class Epi, class Sched, bool ALIGN_EPI = false, bool SP2 = false>
__device__ __forceinline__ void gemm_phase(PG8_LAS unsigned char* lds, const Gemm g, const Sched& S, const Epi& E, const int wv  ) {
    const int tid_ = (wv << 6) | lane_now();
    const int tid = tid_, wid = __builtin_amdgcn_readfirstlane(tid >> 6), lane = tid & 63, wr = wid >> 2, wc = wid & 3, fr = lane & 15, fq = lane >> 4;
    const int K = g.K, nt = K / BK;
    unsigned voffA[2], voffB[2];
#pragma unroll
    for (int i = 0; i < 2; ++i) { int R, C; stage_rc(tid * 16 + i * 8192, R, C); const int Rb = Epi::PERM ? ((R & ~31) + perm32(R & 31)) : R;
        voffA[i] = (unsigned)(R * K + C) * 2u; voffB[i] = (unsigned)(Rb * K + C) * 2u; }
    const size_t kstep = (size_t)(BK * 2);
    const size_t hstep = (size_t)HALF * K * 2;
    const size_t tstep = 2 * hstep;
    const unsigned ldsw = (unsigned)wid * 1024u;
    const int aoff = lds_byte(wr * 64 + fr, fq * 8), boff = lds_byte(wc * 32 + fr, fq * 8);
#define PG8_SA(b, h) (((b) * 2 + (h)) * HTB)
#define PG8_SB(b, h) ((4 + (b) * 2 + (h)) * HTB)
#define PG8_STAGE(bufoff, gbase, voff) do { _Pragma("unroll") for (int _i = 0; _i < 2; ++_i) \
        __builtin_amdgcn_global_load_lds((const unsigned*)((const char*)(gbase) + (voff)[_i]), (PG8_LAS unsigned*)(lds + (bufoff) + ldsw + _i * 8192), 16, 0, 0); } while (0)
#define PG8_LDA(dst, b, h) do { _Pragma("unroll") for (int m = 0; m < 4; ++m) _Pragma("unroll") for (int k = 0; k < 2; ++k) dst[m][k] = *(const PG8_LAS bf16x8*)(lds + PG8_SA(b, h) + aoff + m * 2048 + k * 1024); } while (0)
#define PG8_LDB(dst, b, h) do { _Pragma("unroll") for (int n = 0; n < 2; ++n) _Pragma("unroll") for (int k = 0; k < 2; ++k) dst[n][k] = *(const PG8_LAS bf16x8*)(lds + PG8_SB(b, h) + boff + n * 2048 + k * 1024); } while (0)
#define PG8_MMA(ai, bj, At, Bt) do { __builtin_amdgcn_s_setprio(1); _Pragma("unroll") for (int m = 0; m < 4; ++m) _Pragma("unroll") for (int n = 0; n < 2; ++n) _Pragma("unroll") for (int k = 0; k < 2; ++k) \
        acc[ai][bj][m][n] = __builtin_amdgcn_mfma_f32_16x16x32_bf16(Bt[n][k], At[m][k], acc[ai][bj][m][n], 0, 0, 0); __builtin_amdgcn_s_setprio(0); } while (0)
#define PG8_WAIT_V(n) asm volatile("s_waitcnt vmcnt(" #n ")" ::: "memory")
#define PG8_WAIT_L(n) asm volatile("s_waitcnt lgkmcnt(" #n ")" ::: "memory")
#define PG8_BAR __builtin_amdgcn_s_barrier()
#define PG8_SCHED __builtin_amdgcn_sched_barrier(0)
    Unit cur, nxt; int ui = 0;
    if (!S.next(0, cur)) return;
    f32x4 acc[2][2][4][2];
#pragma unroll
    for (int a = 0; a < 2; ++a)
#pragma unroll
        for (int b = 0; b < 2; ++b)
#pragma unroll
            for (int m = 0; m < 4; ++m)
#pragma unroll
                for (int n = 0; n < 2; ++n) acc[a][b][m][n] = (f32x4){0.f, 0.f, 0.f, 0.f};
    bf16x8 At[4][2], B0[2][2], B1[2][2];
    const char* cA = (const char*)g.A + (size_t)cur.pm * tstep; const char* cB = (const char*)g.Bt + (size_t)cur.pn * tstep;
    S.a_ready(cur);
    if constexpr (SP2) {
        PG8_STAGE(PG8_SB(0, 0), cB, voffB); PG8_STAGE(PG8_SB(0, 1), cB + hstep, voffB); PG8_STAGE(PG8_SA(0, 0), cA, voffA); PG8_STAGE(PG8_SA(0, 1), cA + hstep, voffA);
        if (wr == 1) PG8_BAR;
        PG8_WAIT_V(2); PG8_BAR;
        PG8_STAGE(PG8_SB(1, 0), cB + kstep, voffB); PG8_STAGE(PG8_SA(1, 0), cA + kstep, voffA); PG8_STAGE(PG8_SB(1, 1), cB + hstep + kstep, voffB);
        PG8_WAIT_V(6); PG8_BAR;
    } else {
        PG8_STAGE(PG8_SB(0, 0), cB, voffB); PG8_STAGE(PG8_SA(0, 0), cA, voffA); PG8_STAGE(PG8_SB(0, 1), cB + hstep, voffB); PG8_STAGE(PG8_SA(0, 1), cA + hstep, voffA);
        if (wr == 1) PG8_BAR;
        PG8_WAIT_V(4); PG8_BAR;
        PG8_STAGE(PG8_SB(1, 0), cB + kstep, voffB); PG8_STAGE(PG8_SA(1, 0), cA + kstep, voffA); PG8_STAGE(PG8_SB(1, 1), cB + hstep + kstep, voffB);
        PG8_WAIT_V(6); PG8_BAR;
    }
    for (;;) {
        const bool has_next = S.next(ui + 1, nxt);
        const char* nA = has_next ? (const char*)g.A + (size_t)nxt.pm * tstep : cA; const char* nB = has_next ? (const char*)g.Bt + (size_t)nxt.pn * tstep : cB;
        for (int t = 0; t < nt; t += 2) {
            const bool last = (t == nt - 2);
            const char* a1 = cA + (size_t)(t + 1) * kstep;
            const char* a2 = last ? nA : cA + (size_t)(t + 2) * kstep; const char* b2 = last ? nB : cB + (size_t)(t + 2) * kstep;
            const char* a3 = a2 + kstep; const char* b3 = b2 + kstep;
            if (last && has_next) S.a_ready(nxt);
            if constexpr (SP2) {
            PG8_LDB(B0, 0, 0); PG8_LDB(B1, 0, 1); PG8_SCHED; PG8_LDA(At, 0, 0); PG8_STAGE(PG8_SA(1, 1), a1 + hstep, voffA);
            PG8_WAIT_V(8); PG8_WAIT_L(0); PG8_BAR; PG8_MMA(0, 0, At, B0); PG8_MMA(0, 1, At, B1); PG8_BAR; PG8_SCHED;
            PG8_LDA(At, 0, 1); PG8_STAGE(PG8_SB(0, 0), b2, voffB); PG8_STAGE(PG8_SB(0, 1), b2 + hstep, voffB); PG8_STAGE(PG8_SA(0, 0), a2, voffA);
            PG8_WAIT_V(8); PG8_WAIT_L(0); PG8_BAR; PG8_MMA(1, 0, At, B0); PG8_MMA(1, 1, At, B1); PG8_BAR; PG8_SCHED;
            PG8_LDB(B0, 1, 0); PG8_LDB(B1, 1, 1); PG8_SCHED; PG8_LDA(At, 1, 0); PG8_STAGE(PG8_SA(0, 1), a2 + hstep, voffA);
            PG8_WAIT_V(8); PG8_WAIT_L(0); PG8_BAR; PG8_MMA(0, 0, At, B0); PG8_MMA(0, 1, At, B1); PG8_BAR; PG8_SCHED;
            PG8_LDA(At, 1, 1); PG8_STAGE(PG8_SB(1, 0), b3, voffB); PG8_STAGE(PG8_SB(1, 1), b3 + hstep, voffB); PG8_STAGE(PG8_SA(1, 0), a3, voffA);
            PG8_WAIT_V(8); PG8_WAIT_L(0); PG8_BAR; PG8_MMA(1, 0, At, B0); PG8_MMA(1, 1, At, B1); PG8_BAR; PG8_SCHED;
            } else {
            PG8_LDB(B0, 0, 0); PG8_SCHED; PG8_LDA(At, 0, 0); PG8_STAGE(PG8_SA(1, 1), a1 + hstep, voffA);
            PG8_WAIT_L(8); PG8_BAR; PG8_WAIT_L(0); PG8_MMA(0, 0, At, B0); PG8_BAR; PG8_SCHED;
            PG8_LDB(B1, 0, 1); PG8_STAGE(PG8_SB(0, 0), b2, voffB);
            PG8_BAR; PG8_WAIT_L(0); PG8_MMA(0, 1, At, B1); PG8_BAR;
            PG8_LDA(At, 0, 1); PG8_STAGE(PG8_SA(0, 0), a2, voffA);
            PG8_BAR; PG8_WAIT_L(0); PG8_MMA(1, 0, At, B0); PG8_BAR; PG8_SCHED;
            PG8_STAGE(PG8_SB(0, 1), b2 + hstep, voffB);
            PG8_WAIT_V(6); PG8_BAR; PG8_MMA(1, 1, At, B1); PG8_BAR;
            PG8_LDB(B0, 1, 0); PG8_SCHED; PG8_LDA(At, 1, 0); PG8_STAGE(PG8_SA(0, 1), a2 + hstep, voffA);
            PG8_WAIT_L(8); PG8_BAR; PG8_WAIT_L(0); PG8_MMA(0, 0, At, B0); PG8_BAR; PG8_SCHED;
            PG8_LDB(B1, 1, 1); PG8_STAGE(PG8_SB(1, 0), b3, voffB);
            PG8_BAR; PG8_WAIT_L(0); PG8_MMA(0, 1, At, B1); PG8_BAR;
            PG8_LDA(At, 1, 1); PG8_STAGE(PG8_SA(1, 0), a3, voffA);
            PG8_BAR; PG8_WAIT_L(0); PG8_MMA(1, 0, At, B0); PG8_BAR; PG8_SCHED;
            PG8_STAGE(PG8_SB(1, 1), b3 + hstep, voffB);
            PG8_WAIT_V(6); PG8_BAR; PG8_MMA(1, 1, At, B1); PG8_BAR;
            }
        }
        if constexpr (ALIGN_EPI) { if (wr == 0) PG8_BAR; }
        if constexpr (!Epi::AFTER_DRAIN) { E(acc, cur, wr, wc, fr, fq); S.done(cur); }
        if (!has_next) break;
#pragma unroll
        for (int a = 0; a < 2; ++a)
#pragma unroll
            for (int b = 0; b < 2; ++b)
#pragma unroll
                for (int m = 0; m < 4; ++m)
#pragma unroll
                    for (int n = 0; n < 2; ++n) acc[a][b][m][n] = (f32x4){0.f, 0.f, 0.f, 0.f};
        cur = nxt; cA = nA; cB = nB; ++ui;
        if constexpr (ALIGN_EPI) { if (wr == 1) PG8_BAR; }
    }
    PG8_WAIT_V(0);
    if constexpr (!ALIGN_EPI) { if (wr == 0) PG8_BAR; }
    PG8_BAR;
    if constexpr (Epi::AFTER_DRAIN) { E.fused(acc, cur, wr, wc, fr, fq, lds, wid, lane); S.done(cur); }
#undef PG8_SA
#undef PG8_SB
#undef PG8_STAGE
#undef PG8_LDA
#undef PG8_LDB
#undef PG8_MMA
#undef PG8_WAIT_V
#undef PG8_WAIT_L
#undef PG8_BAR
#undef PG8_SCHED
}
}
namespace att {
typedef unsigned short bf16_t;
using bf16x8 = __attribute__((ext_vector_type(8))) short;
using s16x4  = __attribute__((ext_vector_type(4))) short;
using f32x16 = __attribute__((ext_vector_type(16))) float;
using u32x4  = __attribute__((ext_vector_type(4))) unsigned;
constexpr int NW = 8, QBLK = 32, KVBLK = 64;
constexpr int SHM_V = KVBLK * 64 * 2, SHM_K = KVBLK * 128 * 2, SHM_ATTN = 2 * SHM_V + 2 * SHM_K + NW * 64 * 4;
#define KSWZ(row, colB) ((row) * 256 + ((colB) ^ (((row) & 7) << 4)))
#define SBAR() __builtin_amdgcn_sched_barrier(0)
__device__ __forceinline__ int crow(int r, int hi) { return (r & 3) + 8 * (r >> 2) + 4 * hi; }
__device__ __forceinline__ unsigned cvtpk(float lo, float hi) { unsigned r; asm volatile("v_cvt_pk_bf16_f32 %0, %1, %2" : "=v"(r) : "v"(lo), "v"(hi)); return r; }
__device__ __forceinline__ void partialSM(f32x16& p0, f32x16& p1, float& m_reg, float& mn, float& alpha, const float C, const float thr) {
  float pmax = p0[0];
#pragma unroll
  for (int r = 1; r < 16; ++r) pmax = fmaxf(pmax, p0[r]);
#pragma unroll
  for (int r = 0; r < 16; ++r) pmax = fmaxf(pmax, p1[r]);
  { auto rr = __builtin_amdgcn_permlane32_swap(__float_as_uint(pmax), __float_as_uint(pmax), false, false);
    pmax = fmaxf(__uint_as_float(rr[0]), __uint_as_float(rr[1])); }
  if (__builtin_expect(__all(pmax - m_reg <= thr), 1)) { mn = m_reg; alpha = 1.f; }
  else { mn = fmaxf(m_reg, pmax); alpha = __builtin_amdgcn_exp2f((m_reg - mn) * C); m_reg = mn; }
  const float mnC = -mn * C;
#pragma unroll
  for (int r = 0; r < 16; ++r) p0[r] = fmaf(p0[r], C, mnC);
#pragma unroll
  for (int r = 0; r < 16; ++r) p1[r] = fmaf(p1[r], C, mnC);
#pragma unroll
  for (int r = 0; r < 16; ++r) p0[r] = __builtin_amdgcn_exp2f(p0[r]);
}
__device__ __forceinline__ void finishSM(f32x16& p0, f32x16& p1, float alpha, float& l_reg, bf16x8& pa0, bf16x8& pa1, bf16x8& pa2, bf16x8& pa3) {
#pragma unroll
  for (int r = 0; r < 16; ++r) p1[r] = __builtin_amdgcn_exp2f(p1[r]);
  float ps = 0;
#pragma unroll
  for (int r = 0; r < 16; ++r) ps += p0[r];
#pragma unroll
  for (int r = 0; r < 16; ++r) ps += p1[r];
  { auto rr = __builtin_amdgcn_permlane32_swap(__float_as_uint(ps), __float_as_uint(ps), false, false);
    ps = __uint_as_float(rr[0]) + __uint_as_float(rr[1]); }
  l_reg = l_reg * alpha + ps;
#define PK4(P, BASE, OUT) do { unsigned a0 = cvtpk(P[BASE + 0], P[BASE + 1]), a1 = cvtpk(P[BASE + 2], P[BASE + 3]);   \
    unsigned b0 = cvtpk(P[BASE + 4], P[BASE + 5]), b1 = cvtpk(P[BASE + 6], P[BASE + 7]);                              \
    auto r0 = __builtin_amdgcn_permlane32_swap(a0, b0, false, false); auto r1 = __builtin_amdgcn_permlane32_swap(a1, b1, false, false); \
    u32x4 w = {r0[0], r1[0], r0[1], r1[1]}; OUT = *reinterpret_cast<bf16x8*>(&w); } while (0)
  PK4(p0, 0, pa0); PK4(p0, 8, pa1); PK4(p1, 0, pa2); PK4(p1, 8, pa3);
#undef PK4
}
template <int NQD> __device__ __forceinline__ void qkt(f32x16& p0, f32x16& p1, const char* Ks, const bf16x8* qr, int r32, int hi) {
  p0 = f32x16{}; p1 = f32x16{};
#pragma unroll
  for (int d0 = 0; d0 < NQD; ++d0) { const int cb = (d0 * 16 + hi * 8) * 2;
    const bf16x8 b0 = *reinterpret_cast<const bf16x8*>(Ks + KSWZ(r32, cb));
    const bf16x8 b1 = *reinterpret_cast<const bf16x8*>(Ks + KSWZ(32 + r32, cb));
    p0 = __builtin_amdgcn_mfma_f32_32x32x16_bf16(b0, qr[d0], p0, 0, 0, 0);
    p1 = __builtin_amdgcn_mfma_f32_32x32x16_bf16(b1, qr[d0], p1, 0, 0, 0); }
}
__device__ __forceinline__ int v_st(int k, int c) { const int kk = (k & ~0xC) | ((k & 4) << 1) | ((k & 8) >> 1); return ((kk >> 3) * 2 + (c >> 5)) * 512 + ((kk & 7) * 32 + (c & 31)) * 2; }
__device__ __forceinline__ int v_rd_base(int lane) { return ((lane & 3) << 3) | (((lane >> 2) & 3) << 6) | (((lane >> 4) & 1) << 5) | (((lane >> 5) & 1) << 8); }
constexpr int v_rd_off(int d0, int ks, int half) { return d0 * 512 + ks * 2048 + half * 1024; }
template <int OFF> __device__ __forceinline__ s16x4 tr_read(int vb) {
  s16x4 r; asm volatile("ds_read_b64_tr_b16 %0, %1 offset:%2" : "=&v"(r) : "v"(vb), "i"(OFF) : "memory"); return r;
}
template <int D0> __device__ __forceinline__ void pv_one(f32x16& od, int vb, bf16x8 pa0, bf16x8 pa1, bf16x8 pa2, bf16x8 pa3) {
  const s16x4 l0 = tr_read<v_rd_off(D0, 0, 0)>(vb), h0 = tr_read<v_rd_off(D0, 0, 1)>(vb), l1 = tr_read<v_rd_off(D0, 1, 0)>(vb), h1 = tr_read<v_rd_off(D0, 1, 1)>(vb);
  const s16x4 l2 = tr_read<v_rd_off(D0, 2, 0)>(vb), h2 = tr_read<v_rd_off(D0, 2, 1)>(vb), l3 = tr_read<v_rd_off(D0, 3, 0)>(vb), h3 = tr_read<v_rd_off(D0, 3, 1)>(vb);
  asm volatile("s_waitcnt lgkmcnt(0)" ::: "memory"); SBAR();
#define PK(L, H) (bf16x8){L[0], L[1], L[2], L[3], H[0], H[1], H[2], H[3]}
  od = __builtin_amdgcn_mfma_f32_32x32x16_bf16(pa0, PK(l0, h0), od, 0, 0, 0);
  od = __builtin_amdgcn_mfma_f32_32x32x16_bf16(pa1, PK(l1, h1), od, 0, 0, 0);
  od = __builtin_amdgcn_mfma_f32_32x32x16_bf16(pa2, PK(l2, h2), od, 0, 0, 0);
  od = __builtin_amdgcn_mfma_f32_32x32x16_bf16(pa3, PK(l3, h3), od, 0, 0, 0);
#undef PK
}
__device__ __forceinline__ void pv2(f32x16* o, int vb, bf16x8 pa0, bf16x8 pa1, bf16x8 pa2, bf16x8 pa3) {
  pv_one<0>(o[0], vb, pa0, pa1, pa2, pa3); pv_one<1>(o[1], vb, pa0, pa1, pa2, pa3);
}
struct Tensors { const bf16_t *Q, *KN, *KR, *V; bf16_t* O; const int* pos; const float* sink; };
constexpr int SEQ = 16384;
template <int MODE>
__device__ __forceinline__ void unit(const Tensors& T, int h, int qb, char* lds, const int wv) {
  constexpr int NQD = MODE == 0 ? 6 : 4;
  constexpr int LDQ = MODE == 0 ? 1536 : 1024, LDK = MODE == 0 ? 1024 : 256, LDO = 1024;
  constexpr float SCALE = MODE == 0 ? 0.10206207261596575f : 0.125f;
  constexpr float C = SCALE * 1.4426950408889634f;
  constexpr float CM = 1.0f, THRS = 11.5f;
  const int tid_ = (wv << 6) | lane_now();
  const int tid = tid_, wid = tid >> 6, lane = tid & 63, r32 = lane & 31, hi = lane >> 5;
  char* V_lds = lds; char* K_lds = lds + 2 * SHM_V;
  float* ws = (float*)(lds + 2 * SHM_V + 2 * SHM_K) + wid * 64; float* li_l = ws; float* al_l = ws + 32;
  const int q0 = qb * 256, kh = MODE == 0 ? h : (h >> 2);
  const bf16_t* Kn = T.KN + kh * 64; const bf16_t* Vh = T.V + kh * 64;
  const int qi = q0 + wid * QBLK + r32;
  const bf16_t* Qw = T.Q + (size_t)qi * LDQ + hi * 8;
  bf16x8 qr[NQD];
#pragma unroll
  for (int d0 = 0; d0 < 4; ++d0) qr[d0] = *reinterpret_cast<const bf16x8*>(Qw + h * 64 + d0 * 16);
  if constexpr (MODE == 0) {
#pragma unroll
    for (int d0 = 4; d0 < 6; ++d0) qr[d0] = *reinterpret_cast<const bf16x8*>(Qw + 1024 + h * 32 + (d0 - 4) * 16);
  }
  float m_reg = -1e30f, l_reg = 0.f; int posq = 0; float slope2 = 0.f;
  if constexpr (MODE == 1) { m_reg = T.sink[h] * 1.4426950408889634f; l_reg = 1.0f; posq = T.pos[qi]; slope2 = __builtin_amdgcn_exp2f(-0.5f * (float)(h + 1)) * 1.4426950408889634f; }
  int t_lo = 0, NT = SEQ / KVBLK;
  if constexpr (MODE == 1) { t_lo = 4 * qb - 2; int t_hi = 4 * qb + 6; if (t_lo < 0) t_lo = 0; if (t_hi > SEQ / KVBLK) t_hi = SEQ / KVBLK; NT = t_hi - t_lo; }
  f32x16 o[2] = {};
  const int sr = tid >> 3, sc = (tid & 7) * 8;
  const int vst = v_st(sr, sc), kst = KSWZ(sr, sc * 2), krst = KSWZ(sr, 128 + (tid & 7) * 8);
  const int vb0 = (int)(uintptr_t)V_lds + v_rd_base(lane);
  bf16x8 vsA, ksA, vsB, ksB; s16x4 krA = {}, krB = {};
#define SLOAD(VS, KS, KRR, tt) do { const size_t k0_ = (size_t)(t_lo + (tt)) * KVBLK + sr; VS = *reinterpret_cast<const bf16x8*>(Vh + k0_ * LDK + sc); KS = *reinterpret_cast<const bf16x8*>(Kn + k0_ * LDK + sc); \
    if constexpr (MODE == 0) KRR = *reinterpret_cast<const s16x4*>(T.KR + k0_ * 32 + (tid & 7) * 4); } while (0)
#define SWRITE(b, VS, KS, KRR) do { *(bf16x8*)(V_lds + (b) * SHM_V + vst) = VS; *(bf16x8*)(K_lds + (b) * SHM_K + kst) = KS; \
    if constexpr (MODE == 0) *(s16x4*)(K_lds + (b) * SHM_K + krst) = KRR; } while (0)
#define SWAIT() do { if constexpr (MODE == 0) asm volatile("s_waitcnt vmcnt(3)" ::: "memory"); else asm volatile("s_waitcnt vmcnt(2)" ::: "memory"); } while (0)
#define RESC(a) do { if (__any((a) < 1.f)) { if (hi == 0) al_l[r32] = (a); asm volatile("s_waitcnt lgkmcnt(0)" ::: "memory"); \
    _Pragma("unroll") for (int d = 0; d < 2; ++d) _Pragma("unroll") for (int r = 0; r < 16; ++r) o[d][r] *= al_l[crow(r, hi)]; } } while (0)
#define BIAS(P0, P1, tt) do { if constexpr (MODE == 1) { const int kb_ = (t_lo + (tt)) * KVBLK; \
    _Pragma("unroll") for (int g = 0; g < 4; ++g) { \
      const int4 pk0_ = *reinterpret_cast<const int4*>(T.pos + kb_ + 8 * g + 4 * hi), pk1_ = *reinterpret_cast<const int4*>(T.pos + kb_ + 32 + 8 * g + 4 * hi); \
      const int pv0_[4] = {pk0_.x, pk0_.y, pk0_.z, pk0_.w}, pv1_[4] = {pk1_.x, pk1_.y, pk1_.z, pk1_.w}; \
      _Pragma("unroll") for (int e = 0; e < 4; ++e) { const int r = 4 * g + e; const int k0_ = kb_ + 8 * g + 4 * hi + e, k1_ = k0_ + 32; \
        const float d0_ = (float)abs(posq - pv0_[e]), d1_ = (float)abs(posq - pv1_[e]); \
        P0[r] = (abs(qi - k0_) <= 128) ? fmaf(P0[r], C, -slope2 * d0_) : -1e30f; \
        P1[r] = (abs(qi - k1_) <= 128) ? fmaf(P1[r], C, -slope2 * d1_) : -1e30f; } } } } while (0)
  f32x16 pA0, pA1, pB0, pB1; float mnA, mnB, alA, alB; bf16x8 pa0, pa1, pa2, pa3;
  SLOAD(vsA, ksA, krA, 0); asm volatile("s_waitcnt vmcnt(0)" ::: "memory"); SWRITE(0, vsA, ksA, krA); __syncthreads();
  qkt<NQD>(pA0, pA1, K_lds, qr, r32, hi); BIAS(pA0, pA1, 0); partialSM(pA0, pA1, m_reg, mnA, alA, CM, THRS);
  SLOAD(vsB, ksB, krB, 1); if (2 < NT) SLOAD(vsA, ksA, krA, 2);
  SWAIT(); SWRITE(1, vsB, ksB, krB); __syncthreads();
  for (int j = 1; j + 1 < NT; j += 2) {
    SBAR(); qkt<NQD>(pB0, pB1, K_lds + SHM_K, qr, r32, hi); BIAS(pB0, pB1, j);
    finishSM(pA0, pA1, alA, l_reg, pa0, pa1, pa2, pa3); SBAR();
    SLOAD(vsB, ksB, krB, j + 2); SBAR();
    pv2(o, vb0, pa0, pa1, pa2, pa3); partialSM(pB0, pB1, m_reg, mnB, alB, CM, THRS);
    __syncthreads(); SWAIT(); SWRITE(0, vsA, ksA, krA);
    RESC(alB); __syncthreads();
    SBAR(); qkt<NQD>(pA0, pA1, K_lds, qr, r32, hi); BIAS(pA0, pA1, j + 1);
    finishSM(pB0, pB1, alB, l_reg, pa0, pa1, pa2, pa3); SBAR();
    if (j + 3 < NT) SLOAD(vsA, ksA, krA, j + 3); SBAR();
    pv2(o, vb0 + SHM_V, pa0, pa1, pa2, pa3); partialSM(pA0, pA1, m_reg, mnA, alA, CM, THRS);
    __syncthreads(); SWAIT(); SWRITE(1, vsB, ksB, krB);
    RESC(alA); __syncthreads();
  }
  SBAR(); qkt<NQD>(pB0, pB1, K_lds + SHM_K, qr, r32, hi); BIAS(pB0, pB1, NT - 1);
  finishSM(pA0, pA1, alA, l_reg, pa0, pa1, pa2, pa3); SBAR();
  pv2(o, vb0, pa0, pa1, pa2, pa3); partialSM(pB0, pB1, m_reg, mnB, alB, CM, THRS);
  __syncthreads(); RESC(alB);
  finishSM(pB0, pB1, alB, l_reg, pa0, pa1, pa2, pa3); SBAR();
  pv2(o, vb0 + SHM_V, pa0, pa1, pa2, pa3);
  if (hi == 0) li_l[r32] = l_reg; asm volatile("s_waitcnt lgkmcnt(0)" ::: "memory");
  float rli[16];
#pragma unroll
  for (int r = 0; r < 16; ++r) rli[r] = __builtin_amdgcn_rcpf(li_l[crow(r, hi)]);
  bf16_t* Ow = T.O + (size_t)(q0 + wid * QBLK) * LDO + h * 64;
#pragma unroll
  for (int r = 0; r < 16; ++r) { const int orow = crow(r, hi);
#pragma unroll
    for (int d0 = 0; d0 < 2; ++d0) { const float v = o[d0][r] * rli[r]; Ow[(size_t)orow * LDO + d0 * 32 + r32] = (bf16_t)(cvtpk(v, v) & 0xffffu); } }
  __syncthreads();
#undef SLOAD
#undef SWRITE
#undef SWAIT
#undef RESC
#undef BIAS
}

__device__ __forceinline__ bool unit_fast(const Tensors& T, const unsigned* knmax, int h, int qb, char* lds, const int wv) {
  constexpr int NQD = 6, LDQ = 1536, LDK = 1024, LDO = 1024;
  const int tid_ = (wv << 6) | lane_now();
  const int tid = tid_, wid = tid >> 6, lane = tid & 63, r32 = lane & 31, hi = lane >> 5;
  char* V_lds = lds; char* K_lds = lds + 2 * SHM_V;
  float* ws = (float*)(lds + 2 * SHM_V + 2 * SHM_K) + wid * 64; float* li_l = ws;
  const int q0 = qb * 256;
  const bf16_t* Kn = T.KN + h * 64; const bf16_t* Vh = T.V + h * 64;
  const int qi = q0 + wid * QBLK + r32;
  const bf16_t* Qw = T.Q + (size_t)qi * LDQ + hi * 8;
  bf16x8 qr[NQD];
#pragma unroll
  for (int d0 = 0; d0 < 4; ++d0) qr[d0] = *reinterpret_cast<const bf16x8*>(Qw + h * 64 + d0 * 16);
#pragma unroll
  for (int d0 = 4; d0 < 6; ++d0) qr[d0] = *reinterpret_cast<const bf16x8*>(Qw + 1024 + h * 32 + (d0 - 4) * 16);
  float qn2 = 0.f;
#pragma unroll
  for (int d0 = 0; d0 < NQD; ++d0)
#pragma unroll
    for (int e = 0; e < 8; ++e) { const float v = __uint_as_float(((unsigned)(unsigned short)qr[d0][e]) << 16); qn2 += v * v; }
  { auto rr = __builtin_amdgcn_permlane32_swap(__float_as_uint(qn2), __float_as_uint(qn2), false, false); qn2 = __uint_as_float(rr[0]) + __uint_as_float(rr[1]); }
  size_t kz_ = 0; asm volatile("" : "+s"(kz_)); const unsigned* kmp = knmax + kz_;
  const float kn2 = __uint_as_float(kmp[2 * h]) + __uint_as_float(kmp[2 * h + 1]) + __uint_as_float(kmp[32]);
  const float mb = sqrtf(qn2 * kn2) * 1.01f + 1.0f;
  f32x16 negm;
#pragma unroll
  for (int r = 0; r < 16; ++r) negm[r] = -mb;
  asm volatile("" : "+v"(negm));
  float l_reg = 0.f;
  constexpr int NT = SEQ / KVBLK;
  f32x16 o[2] = {};
  const int sr = tid >> 3, sc = (tid & 7) * 8;
  const int vst = v_st(sr, sc), kst = KSWZ(sr, sc * 2), krst = KSWZ(sr, 128 + (tid & 7) * 8);
  const int vb0 = (int)(uintptr_t)V_lds + v_rd_base(lane);
  bf16x8 vsR, ksR; s16x4 krR;
#define SLOADK(tt) do { const size_t k0_ = (size_t)(tt) * KVBLK + sr; ksR = *reinterpret_cast<const bf16x8*>(Kn + k0_ * LDK + sc); krR = *reinterpret_cast<const s16x4*>(T.KR + k0_ * 32 + (tid & 7) * 4); } while (0)
#define SLOADV(tt) do { const size_t k0_ = (size_t)(tt) * KVBLK + sr; vsR = *reinterpret_cast<const bf16x8*>(Vh + k0_ * LDK + sc); } while (0)
#define SWRITEK(b) do { *(bf16x8*)(K_lds + (b) * SHM_K + kst) = ksR; *(s16x4*)(K_lds + (b) * SHM_K + krst) = krR; } while (0)
#define SWRITEV(b) do { *(bf16x8*)(V_lds + (b) * SHM_V + vst) = vsR; } while (0)
#ifndef ATT_PRIO
#define ATT_PRIO 1
#endif
#define PRIO_HI() do { if (ATT_PRIO) __builtin_amdgcn_s_setprio(ATT_PRIO); } while (0)
#ifndef ATT_PRIO2
#define ATT_PRIO2 0
#endif
#define PRIO2_HI() do { if (ATT_PRIO2) __builtin_amdgcn_s_setprio(ATT_PRIO2); } while (0)
#define PRIO2_LO() do { if (ATT_PRIO2) __builtin_amdgcn_s_setprio(0); } while (0)
#ifndef ATT_PRIOM
#define ATT_PRIOM 0
#endif
#define PRIO_MID() do { if (ATT_PRIOM) __builtin_amdgcn_s_setprio(0); } while (0)
#define PRIO_LO() do { if (ATT_PRIO) __builtin_amdgcn_s_setprio(0); } while (0)
#define QKT(P0, P1, Ks) do { \
    _Pragma("unroll") for (int d0 = 0; d0 < NQD; ++d0) { const int cb = (d0 * 16 + hi * 8) * 2; \
      const bf16x8 b0 = *reinterpret_cast<const bf16x8*>((Ks) + KSWZ(r32, cb)); const bf16x8 b1 = *reinterpret_cast<const bf16x8*>((Ks) + KSWZ(32 + r32, cb)); \
      if (d0 == 0) { P0 = __builtin_amdgcn_mfma_f32_32x32x16_bf16(b0, qr[0], negm, 0, 0, 0); P1 = __builtin_amdgcn_mfma_f32_32x32x16_bf16(b1, qr[0], negm, 0, 0, 0); } \
      else { P0 = __builtin_amdgcn_mfma_f32_32x32x16_bf16(b0, qr[d0], P0, 0, 0, 0); P1 = __builtin_amdgcn_mfma_f32_32x32x16_bf16(b1, qr[d0], P1, 0, 0, 0); } } } while (0)
#define EXPH(P) do { _Pragma("unroll") for (int r = 0; r < 16; ++r) P[r] = __builtin_amdgcn_exp2f(P[r]); } while (0)
#define PK4(P, BASE, OUT) do { unsigned a0 = cvtpk(P[BASE + 0], P[BASE + 1]), a1 = cvtpk(P[BASE + 2], P[BASE + 3]);   \
    unsigned b0 = cvtpk(P[BASE + 4], P[BASE + 5]), b1 = cvtpk(P[BASE + 6], P[BASE + 7]);                              \
    auto r0 = __builtin_amdgcn_permlane32_swap(a0, b0, false, false); auto r1 = __builtin_amdgcn_permlane32_swap(a1, b1, false, false); \
    u32x4 w = {r0[0], r1[0], r0[1], r1[1]}; OUT = *reinterpret_cast<bf16x8*>(&w); } while (0)
#ifndef EXP_ALL_IN_FIN
#define EXP_ALL_IN_FIN 0
#endif
#define EXPC(P) do { if (!EXP_ALL_IN_FIN) EXPH(P); } while (0)
#define FIN(P0, P1) do { if (EXP_ALL_IN_FIN) EXPH(P0); EXPH(P1); float ps = 0.f; _Pragma("unroll") for (int r = 0; r < 16; ++r) ps += P0[r]; _Pragma("unroll") for (int r = 0; r < 16; ++r) ps += P1[r]; l_reg += ps; \
    PK4(P0, 0, pa0); PK4(P0, 8, pa1); PK4(P1, 0, pa2); PK4(P1, 8, pa3); } while (0)
  f32x16 pA0, pA1, pB0, pB1; bf16x8 pa0, pa1, pa2, pa3;
  SLOADK(0); asm volatile("s_waitcnt vmcnt(0)" ::: "memory"); SWRITEK(0); SLOADK(1); SLOADV(0); __syncthreads();
  SWRITEK(1); SWRITEV(0); SLOADK(2); SLOADV(1);
  SBAR(); QKT(pA0, pA1, K_lds); EXPC(pA0);
  for (int t = 1; t + 1 < NT; t += 2) {
    __syncthreads();
    SWRITEK(0); SWRITEV(1); SLOADK(t + 2); SLOADV(t + 1);
    SBAR(); PRIO_HI(); QKT(pB0, pB1, K_lds + SHM_K); PRIO_MID();
    FIN(pA0, pA1); PRIO_LO(); SBAR();
    PRIO2_HI(); pv2(o, vb0, pa0, pa1, pa2, pa3); PRIO2_LO(); EXPC(pB0);
    __syncthreads();
    SWRITEK(1); SWRITEV(0); if (t + 3 < NT) SLOADK(t + 3); SLOADV(t + 2);
    SBAR(); PRIO_HI(); QKT(pA0, pA1, K_lds); PRIO_MID();
    FIN(pB0, pB1); PRIO_LO(); SBAR();
    PRIO2_HI(); pv2(o, vb0 + SHM_V, pa0, pa1, pa2, pa3); PRIO2_LO(); EXPC(pA0);
  }
  __syncthreads();
  SWRITEV(1);
  SBAR(); QKT(pB0, pB1, K_lds + SHM_K);
  FIN(pA0, pA1); SBAR();
  pv2(o, vb0, pa0, pa1, pa2, pa3); EXPC(pB0);
  __syncthreads();
  FIN(pB0, pB1); SBAR();
  pv2(o, vb0 + SHM_V, pa0, pa1, pa2, pa3);
  { auto rr = __builtin_amdgcn_permlane32_swap(__float_as_uint(l_reg), __float_as_uint(l_reg), false, false); l_reg = __uint_as_float(rr[0]) + __uint_as_float(rr[1]); }
  volatile unsigned* flg = (volatile unsigned*)(lds + 2 * SHM_V + 2 * SHM_K + NW * 64 * 4);
  { const unsigned myb = __any(!(l_reg >= 1e-30f && l_reg < 3e38f)) ? 1u : 0u; if (lane == 0) flg[wid] = myb; }
  __syncthreads();
  unsigned bad = 0u;
#pragma unroll
  for (int w = 0; w < NW; ++w) bad |= flg[w];
  if (bad) return true;
  if (hi == 0) li_l[r32] = l_reg; asm volatile("s_waitcnt lgkmcnt(0)" ::: "memory");
  float rli[16];
#pragma unroll
  for (int r = 0; r < 16; ++r) rli[r] = __builtin_amdgcn_rcpf(li_l[crow(r, hi)]);
  bf16_t* Ow = T.O + (size_t)(q0 + wid * QBLK) * LDO + h * 64;
#pragma unroll
  for (int r = 0; r < 16; ++r) { const int orow = crow(r, hi);
#pragma unroll
    for (int d0 = 0; d0 < 2; ++d0) { const float v = o[d0][r] * rli[r]; Ow[(size_t)orow * LDO + d0 * 32 + r32] = (bf16_t)(cvtpk(v, v) & 0xffffu); } }
  return false;
#undef SLOADK
#undef SLOADV
#undef SWRITEK
#undef SWRITEV
#undef QKT
#undef EXPH
#undef PK4
#undef FIN
#undef EXPC
}
#undef SBAR
}
#define GAS __attribute__((address_space(1)))
#define LAS __attribute__((address_space(3)))
typedef unsigned short bf16;
typedef unsigned v4u __attribute__((ext_vector_type(4)));
typedef float f32x4 __attribute__((ext_vector_type(4)));
constexpr int NWAVES = 8;
#ifndef REP_T
#define REP_T 1
#endif
#ifndef REP_H
#define REP_H 1
#endif
#ifndef REP_W
#define REP_W 1
#endif
#ifndef REP_G2
#define REP_G2 1
#endif
#ifndef REP_P0
#define REP_P0 1
#endif
#ifndef REP_P2
#define REP_P2 1
#endif
#ifndef REP_P3
#define REP_P3 1
#endif
#ifndef REP_P4
#define REP_P4 1
#endif
#ifndef REP_P7
#define REP_P7 1
#endif
constexpr int M = 16384, DM = 2048, DFF = 8192, NIN_SRC = 6432, NIN = 6656;
constexpr size_t MiB = 1u << 20;
constexpr size_t WS_WIN = 0 * MiB, WS_WUQ = 26 * MiB, WS_WUKV = 28 * MiB, WS_WA = 29 * MiB, WS_WB = 33 * MiB, WS_WOUT = 37 * MiB, WS_W1 = 45 * MiB, WS_W2 = 77 * MiB;
constexpr size_t WS_SSQ = 110 * MiB;
constexpr size_t WS_ROPEC = 111 * MiB, WS_ROPES = 112 * MiB;
constexpr size_t WS_CTL = 113 * MiB;
constexpr size_t WS_GA = 116 * MiB, WS_GB = 180 * MiB, WS_QA = 244 * MiB, WS_KA = 276 * MiB, WS_VA = 284 * MiB, WS_CQ = 292 * MiB, WS_CKV = 308 * MiB, WS_KR = 316 * MiB;
constexpr size_t WS_Q = 320 * MiB, WS_KN = 368 * MiB, WS_V = 400 * MiB, WS_OA = 432 * MiB, WS_OB = 464 * MiB;
constexpr size_t WS_H = 436 * MiB;
constexpr size_t WS_T1 = 244 * MiB, WS_MG = 308 * MiB, WS_X1B = 372 * MiB, WS_U = 116 * MiB, WS_END = 500 * MiB;
constexpr int RING_BYTES = 131072, LDS_BYTES = 147456;
#define LDS_WAIT() asm volatile("s_waitcnt lgkmcnt(0)" ::: "memory")
__device__ __forceinline__ unsigned f2bf(float f) { unsigned u = __builtin_bit_cast(unsigned, f); return (u + 0x7fffu + ((u >> 16) & 1u)) >> 16; }
__device__ __forceinline__ unsigned pk2(float lo, float hi) { return f2bf(lo) | (f2bf(hi) << 16); }
__device__ __forceinline__ float wave_sum(float v) {
#pragma unroll
    for (int o = 1; o < 64; o <<= 1) v += __shfl_xor(v, o);
    return v;
}
__device__ __forceinline__ int permI(int j) { return j < 16 ? 2 * j : 2 * (j - 16) + 1; }
__device__ __forceinline__ void p0_transpose_item(const float* W, int K, int N, bf16* WT, LAS float* scr, int kb, int n0src, int dest_base, bool perm, const float* gain, int lane, bool nt_store = false) {
    const int k0 = 64 * kb;
#ifndef T_NARROW
#define T_NARROW 8
#endif
#if T_NARROW
#pragma unroll T_NARROW
    for (int i = 0; i < 32; ++i) { const int kk = 2 * i + (lane >> 5); scr[kk * 33 + (lane & 31)] = __builtin_nontemporal_load(W + (size_t)(k0 + kk) * N + n0src + (lane & 31)); }
#else
    { f32x4 v[8];
#pragma unroll
      for (int i = 0; i < 8; ++i) v[i] = *(const GAS f32x4*)(W + (size_t)(k0 + 8 * i + (lane >> 3)) * N + n0src + (lane & 7) * 4);
#pragma unroll
      for (int i = 0; i < 8; ++i) { LAS float* d = scr + (8 * i + (lane >> 3)) * 33 + (lane & 7) * 4; d[0] = v[i].x; d[1] = v[i].y; d[2] = v[i].z; d[3] = v[i].w; } }
#endif
    LDS_WAIT(); asm volatile("" ::: "memory");
    const int c = lane & 7;
    float g[8];
#pragma unroll
    for (int e = 0; e < 8; ++e) g[e] = gain ? gain[k0 + 8 * c + e] : 1.0f;
#pragma unroll
    for (int j = 0; j < 4; ++j) { const int n = (lane >> 3) + 8 * j; const LAS float* s = scr + (8 * c) * 33 + n;
        v4u o; o.x = pk2(s[0 * 33] * g[0], s[1 * 33] * g[1]); o.y = pk2(s[2 * 33] * g[2], s[3 * 33] * g[3]); o.z = pk2(s[4 * 33] * g[4], s[5 * 33] * g[5]); o.w = pk2(s[6 * 33] * g[6], s[7 * 33] * g[7]);
        const int dn = perm ? permI(n) : n;
        GAS v4u* dp = (GAS v4u*)(WT + (size_t)(dest_base + dn) * K + k0 + 8 * c); if (nt_store) __builtin_nontemporal_store(o, dp); else *dp = o; }
    LDS_WAIT(); asm volatile("" ::: "memory");
}
#define XB_TMO      128
#define XB_XCNT(j)  (256  + 64 * (j))
#define XB_XSUB(j)  (1280 + 64 * (j))
#define XB_XGEN(j)  (2304 + 64 * (j))
#define XB_TOP      3328
#define XB_TOPGEN   3392
#define XCD_BAR_WORDS 3456
#define XB_SPIN_CAP (1u << 18)

__device__ __forceinline__ unsigned xb_ld(unsigned* p)              { return __hip_atomic_load(p, __ATOMIC_RELAXED, __HIP_MEMORY_SCOPE_AGENT); }
__device__ __forceinline__ unsigned xb_add(unsigned* p, unsigned v) { return __hip_atomic_fetch_add(p, v, __ATOMIC_RELAXED, __HIP_MEMORY_SCOPE_AGENT); }
__device__ __forceinline__ unsigned xb_xcc_id() { return (unsigned)__builtin_amdgcn_s_getreg((3 << 11) | 20) & 0xFu; }
#define XB_SPIN(cond, bar) do { unsigned _sp = 0; while (cond) { __builtin_amdgcn_s_sleep(1); \
    if ((++_sp & 255u) == 0u) { if (xb_ld(&(bar)[XB_TMO])) break; if (_sp > XB_SPIN_CAP) { atomicAdd(&(bar)[XB_TMO], 1u); break; } } } } while (0)

struct XcdBarrier {
    unsigned* bar; unsigned x;
    volatile LAS unsigned* st;
};

__device__ __forceinline__ XcdBarrier xcd_barrier_post(unsigned* bar, volatile LAS unsigned* st) {
    XcdBarrier b; b.bar = bar; b.x = xb_xcc_id(); b.st = st;
    if (threadIdx.x == 0) (void)xb_add(&bar[XB_XCNT(b.x)], 1u);
    return b;
}
__device__ __forceinline__ void xcd_barrier_complete(unsigned* bar, unsigned x, unsigned& nloc, unsigned& nx) {
    const unsigned G = gridDim.x * gridDim.y * gridDim.z;
    unsigned sum, cnt, mine, sp = 0u;
    for (;;) {
        sum = 0u; cnt = 0u; mine = 0u;
#pragma unroll
        for (unsigned j = 0; j < 16; ++j) { const unsigned c = xb_ld(&bar[XB_XCNT(j)]); sum += c; cnt += (c > 0u) ? 1u : 0u; mine = (j == x) ? c : mine; }
        if (sum == G) break;
        __builtin_amdgcn_s_sleep(1);
        if ((++sp & 255u) == 0u) { if (xb_ld(&bar[XB_TMO])) break; if (sp > XB_SPIN_CAP) { atomicAdd(&bar[XB_TMO], 1u); break; } }
    }
    nloc = mine > 0u ? mine : 1u; nx = cnt > 0u ? cnt : 1u;
}

__device__ __forceinline__ void xcd_barrier(const XcdBarrier& b, const int wave) {
    asm volatile("s_waitcnt vmcnt(0)" ::: "memory");
    __syncthreads();
    if (wave == 0 && lane_now() == 0) {
        unsigned* bar = b.bar;
        __builtin_amdgcn_s_waitcnt(0);
        unsigned nloc = b.st[0], nx = b.st[1];
        if (nloc == 0u) { xcd_barrier_complete(bar, b.x, nloc, nx); b.st[0] = nloc; b.st[1] = nx; }
        const unsigned old = xb_add(&bar[XB_XSUB(b.x)], 1u);
        const unsigned gen = old / nloc;
        if (old + 1u == (gen + 1u) * nloc) {
            __builtin_amdgcn_fence(__ATOMIC_RELEASE, "agent");
            asm volatile("s_waitcnt vmcnt(0)" ::: "memory");
            const unsigned og = xb_add(&bar[XB_TOP], 1u);
            const unsigned tg = og / nx;
            if (og + 1u == (tg + 1u) * nx) xb_add(&bar[XB_TOPGEN], 1u);
            else XB_SPIN(xb_ld(&bar[XB_TOPGEN]) == tg, bar);
            __builtin_amdgcn_fence(__ATOMIC_ACQUIRE, "agent");
            xb_add(&bar[XB_XGEN(b.x)], 1u);
            asm volatile("s_waitcnt vmcnt(0)" ::: "memory");
        } else {
            XB_SPIN(xb_ld(&bar[XB_XGEN(b.x)]) == gen, bar);
            __builtin_amdgcn_fence(__ATOMIC_ACQUIRE, "agent");
            asm volatile("s_waitcnt vmcnt(0)" ::: "memory");
        }
    }
    __syncthreads();
}
__device__ __forceinline__ void grid_bar(unsigned* ctr, unsigned target, int wave) {
    asm volatile("s_waitcnt vmcnt(0) lgkmcnt(0)" ::: "memory");
    __syncthreads();
    if (wave == 0) {
        __builtin_amdgcn_fence(__ATOMIC_RELEASE, "agent");
        if (lane_now() == 0) {
            __hip_atomic_fetch_add(ctr, 1u, __ATOMIC_RELAXED, __HIP_MEMORY_SCOPE_AGENT);
            while (__hip_atomic_load(ctr, __ATOMIC_RELAXED, __HIP_MEMORY_SCOPE_AGENT) < target) __builtin_amdgcn_s_sleep(2);
        }
        __builtin_amdgcn_fence(__ATOMIC_ACQUIRE, "agent");
        asm volatile("s_waitcnt vmcnt(0)" ::: "memory");
    }
    __syncthreads();
}
struct Args { const void* in[17]; float* out; unsigned char* ws; };
__global__ void __launch_bounds__(NWAVES * 64, 2) mega_fwd(Args args) {
    extern __shared__ __attribute__((aligned(16))) unsigned char lds[];
    { cg::grid_group grid = cg::this_grid(); grid.sync(); }
    LAS unsigned char* ldsl = (LAS unsigned char*)lds;
    const int wave = __builtin_amdgcn_readfirstlane((int)threadIdx.x >> 6);
    const int G = gridDim.x, bx = blockIdx.x;
    const int vcu = (G % 8 == 0) ? (bx % 8) * (G / 8) + bx / 8 : bx;
    unsigned char* ws = args.ws;
    const float* x = (const float*)args.in[0]; const int* pos = (const int*)args.in[1]; const float* g_attn = (const float*)args.in[2]; const float* w_in = (const float*)args.in[3];
    const float* a_sink = (const float*)args.in[4]; const float* g_q = (const float*)args.in[5]; const float* g_kv = (const float*)args.in[6];
    const float* w_uq = (const float*)args.in[7]; const float* w_uk = (const float*)args.in[8]; const float* w_uv = (const float*)args.in[9];
    const float* w_a = (const float*)args.in[10]; const float* w_b = (const float*)args.in[11]; const float* w_out = (const float*)args.in[12];
    const float* g_mlp = (const float*)args.in[13]; const float* w_1 = (const float*)args.in[14]; const float* w_2 = (const float*)args.in[15]; const float* g_fin = (const float*)args.in[16];
    float* out = args.out;
#define WSB() ({ size_t z_ = 0; asm volatile("" : "+s"(z_)); ws + z_; })
#define DEFPTRS unsigned char* wsb = WSB(); \
    bf16 *Win_t = (bf16*)(wsb + WS_WIN), *Wuq_t = (bf16*)(wsb + WS_WUQ), *Wukv_t = (bf16*)(wsb + WS_WUKV), *Wa_t = (bf16*)(wsb + WS_WA), *Wb_t = (bf16*)(wsb + WS_WB), *Wout_t = (bf16*)(wsb + WS_WOUT), *W1_t = (bf16*)(wsb + WS_W1), *W2_t = (bf16*)(wsb + WS_W2); \
    float* ssq_q = (float*)(wsb + WS_SSQ); float* ssq_kv = ssq_q + M; float* ssq_x1 = ssq_q + 2 * M; float* ssq_x2 = ssq_q + 3 * M; unsigned* knmax = (unsigned*)(ssq_q + 4 * M); \
    float* ropec = (float*)(wsb + WS_ROPEC); float* ropes = (float*)(wsb + WS_ROPES); \
    bf16 *GA = (bf16*)(wsb + WS_GA), *GB = (bf16*)(wsb + WS_GB), *QA = (bf16*)(wsb + WS_QA), *KA = (bf16*)(wsb + WS_KA), *VA = (bf16*)(wsb + WS_VA), *CQ = (bf16*)(wsb + WS_CQ), *CKV = (bf16*)(wsb + WS_CKV), *KR = (bf16*)(wsb + WS_KR); \
    bf16 *Qb = (bf16*)(wsb + WS_Q), *KN = (bf16*)(wsb + WS_KN), *Vb = (bf16*)(wsb + WS_V), *OA = (bf16*)(wsb + WS_OA), *OB = (bf16*)(wsb + WS_OB), *Hb = (bf16*)(wsb + WS_H); \
    bf16 *T1 = (bf16*)(wsb + WS_T1), *MG = (bf16*)(wsb + WS_MG), *X1B = (bf16*)(wsb + WS_X1B), *Ub = (bf16*)(wsb + WS_U); \
    (void)Win_t; (void)Wuq_t; (void)Wukv_t; (void)Wa_t; (void)Wb_t; (void)Wout_t; (void)W1_t; (void)W2_t; (void)ssq_kv; (void)ssq_x1; (void)ssq_x2; (void)knmax; (void)ropec; (void)ropes; \
    (void)GA; (void)GB; (void)QA; (void)KA; (void)VA; (void)CQ; (void)CKV; (void)KR; (void)Qb; (void)KN; (void)Vb; (void)OA; (void)OB; (void)Hb; (void)T1; (void)MG; (void)X1B; (void)Ub;
    const int gw = vcu * NWAVES + wave, NGW = G * NWAVES, NGT = NGW * 64;
    unsigned bar_target = 0u;
#ifndef REP_BAR
#define REP_BAR 1
#endif
#ifndef USE_XBAR
#define USE_XBAR 1
#endif
#if USE_XBAR
    { volatile LAS unsigned* st_ = (volatile LAS unsigned*)(ldsl + RING_BYTES + 64); if (threadIdx.x < 2) st_[threadIdx.x] = 0u; }
    __syncthreads();
    const XcdBarrier xbar = xcd_barrier_post((unsigned*)(ws + WS_CTL), (volatile LAS unsigned*)(ldsl + RING_BYTES + 64));
#define GRID_BAR() do { for (int rb_ = 0; rb_ < REP_BAR; ++rb_) xcd_barrier(xbar, wave); } while (0)
#else
#define GRID_BAR() do { for (int rb_ = 0; rb_ < REP_BAR; ++rb_) { bar_target += (unsigned)G; grid_bar((unsigned*)(ws + WS_CTL), bar_target, wave); } } while (0)
#endif

    for (int rep = 0; rep < REP_P0; ++rep) { DEFPTRS
        const int lane = lane_now(), gt = gw * 64 + lane;
        for (int i = gt; i < 4 * M + 64; i += NGT) ssq_q[i] = 0.f;
#ifndef REP_R
#define REP_R 1
#endif
        const float inv = (float)exp2(-(double)(gt & 15) * (13.287712379549449 / 16.0));
        for (int rr_ = 0; rr_ < REP_R; ++rr_)
        for (int i = gt; i < M * 16; i += NGT) { const int r = i >> 4;
            const float ang = (float)pos[r] * inv;
            double t = (double)ang * 0.15915494309189535; t -= rint(t); const float fr = (float)t;
            ropec[i] = __builtin_amdgcn_cosf(fr); ropes[i] = __builtin_amdgcn_sinf(fr); }
        for (int i = gt; i < 224 * 2048 / 8; i += NGT) *(GAS v4u*)(Win_t + (size_t)2336 * 2048 + (size_t)i * 8) = (v4u){0u, 0u, 0u, 0u};
        LAS float* scr = (LAS float*)(ldsl + wave * 16384);
        constexpr int I_IN = 32 * 201, I_UQ = 8 * 48, I_UK = 4 * 32, I_A = 16 * 64, I_OUT = 32 * 64, I_1 = 32 * 256, I_2 = 128 * 64;
        constexpr int NITEMS = I_IN + I_UQ + 2 * I_UK + 2 * I_A + I_OUT + I_1 + I_2;
        for (int rt = 0; rt < REP_T; ++rt)
        for (int it = gw; it < NITEMS; it += NGW) {
            int r = it;
            if (r < I_IN) { const int kb = r / 201, nb = r % 201; const int db = nb < 72 ? 32 * nb : (nb == 72 ? 2304 : 32 * nb + 224);
                p0_transpose_item(w_in, 2048, NIN_SRC, Win_t, scr, kb, 32 * nb, db, nb == 72, nullptr, lane); continue; } r -= I_IN;
            if (r < I_UQ) { const int kb = r / 48, nb = r % 48, hh = nb / 3, part = nb % 3; const int db = part < 2 ? hh * 64 + part * 32 : 1024 + hh * 32;
                p0_transpose_item(w_uq, 512, 1536, Wuq_t, scr, kb, 32 * nb, db, part == 2, g_q, lane); continue; } r -= I_UQ;
            if (r < I_UK) { p0_transpose_item(w_uk, 256, 1024, Wukv_t, scr, r / 32, 32 * (r % 32), 32 * (r % 32), false, g_kv, lane); continue; } r -= I_UK;
            if (r < I_UK) { p0_transpose_item(w_uv, 256, 1024, Wukv_t, scr, r / 32, 32 * (r % 32), 1024 + 32 * (r % 32), false, g_kv, lane); continue; } r -= I_UK;
            if (r < I_A) { p0_transpose_item(w_a, 1024, 2048, Wa_t, scr, r / 64, 32 * (r % 64), 32 * (r % 64), false, nullptr, lane, true); continue; } r -= I_A;
            if (r < I_A) { p0_transpose_item(w_b, 1024, 2048, Wb_t, scr, r / 64, 32 * (r % 64), 32 * (r % 64), false, nullptr, lane, true); continue; } r -= I_A;
            if (r < I_OUT) { p0_transpose_item(w_out, 2048, 2048, Wout_t, scr, r / 64, 32 * (r % 64), 32 * (r % 64), false, nullptr, lane, true); continue; } r -= I_OUT;
            if (r < I_1) { p0_transpose_item(w_1, 2048, 8192, W1_t, scr, r / 256, 32 * (r % 256), 32 * (r % 256), false, g_mlp, lane, true); continue; } r -= I_1;
            p0_transpose_item(w_2, 8192, 2048, W2_t, scr, r / 64, 32 * (r % 64), 32 * (r % 64), false, nullptr, lane, true);
        }
        for (int rh = 0; rh < REP_H; ++rh)
        for (int m = gw; m < M; m += NGW) {
            const GAS f32x4* xr = (const GAS f32x4*)(x + (size_t)m * DM) + lane; f32x4 v[8]; float s = 0.f;
#pragma unroll
            for (int j = 0; j < 8; ++j) { v[j] = __builtin_nontemporal_load(xr + 64 * j); s += (v[j].x * v[j].x + v[j].y * v[j].y) + (v[j].z * v[j].z + v[j].w * v[j].w); }
            const float rstd = 1.0f / sqrtf(wave_sum(s) * (1.0f / DM) + 1e-6f);
            GAS unsigned long long* o8 = (GAS unsigned long long*)(Hb + (size_t)m * DM) + lane;
#pragma unroll
            for (int j = 0; j < 8; ++j) { const f32x4 gg = *((const GAS f32x4*)g_attn + lane + 64 * j); const f32x4 y = v[j] * rstd * gg;
                o8[64 * j] = (unsigned long long)pk2(y.x, y.y) | ((unsigned long long)pk2(y.z, y.w) << 32); }
        }
    }
    GRID_BAR();
    { DEFPTRS
        pg8::Gemm g{Hb, Win_t, M, NIN, DM}; pg8::StaticOrder S; S.init(M, NIN, G, bx);
        pg8::EpiRow<pg8::F1> E{{QA, KA, VA, CQ, CKV, KR, GA, GB, ssq_q, ssq_kv, ropec, ropes, knmax}};
        pg8::gemm_phase<pg8::EpiRow<pg8::F1>, pg8::StaticOrder, true, true>(ldsl, g, S, E, wave);
    }
    GRID_BAR();
    for (int rep = 0; rep < REP_P2; ++rep) { DEFPTRS
        { pg8::Gemm g{CQ, Wuq_t, M, 1536, 512}; pg8::StaticOrder S; S.init(M, 1536, G, bx);
          pg8::EpiRow<pg8::F2a> E{{Qb, ssq_q, ropec, ropes}};
          pg8::gemm_phase<pg8::EpiRow<pg8::F2a>, pg8::StaticOrder, true, true>(ldsl, g, S, E, wave); }
        { pg8::Gemm g{CKV, Wukv_t, M, 2048, 256}; pg8::StaticOrder S; S.init(M, 2048, G, bx);
          pg8::EpiRow<pg8::F2b> E{{KN, Vb, ssq_kv, knmax}};
          pg8::gemm_phase<pg8::EpiRow<pg8::F2b>, pg8::StaticOrder, true, true>(ldsl, g, S, E, wave); }
        const att::Tensors TA{QA, KA, nullptr, VA, OA, pos, a_sink};
        for (int rw = 0; rw < REP_W; ++rw)
        for (int u = vcu; u < 1024; u += G) att::unit<1>(TA, u >> 6, u & 63, (char*)lds, wave);
    }
    GRID_BAR();
    for (int rep = 0; rep < REP_P3; ++rep) { DEFPTRS
        const att::Tensors TB{Qb, KN, KR, Vb, OB, pos, a_sink};
        for (int u = vcu; u < 1024; u += G) { int uu = (u % G) * (1024 / G) + u / G;
#ifndef P3_ONE_HEAD_PER_XCD
#define P3_ONE_HEAD_PER_XCD 1
#endif
            if (P3_ONE_HEAD_PER_XCD && G == 256) { const int i_ = u / G, x_ = vcu >> 5, j_ = vcu & 31; uu = ((2 * x_ + (i_ >> 1)) << 6) | (j_ * 2 + (i_ & 1)); }
#ifdef FORCE_SLOW
            att::unit<0>(TB, uu >> 6, uu & 63, (char*)lds, wave); }
#else
            if (att::unit_fast(TB, knmax, uu >> 6, uu & 63, (char*)lds, wave)) att::unit<0>(TB, uu >> 6, uu & 63, (char*)lds, wave); }
#endif
    }
    GRID_BAR();
    for (int rep = 0; rep < REP_P4; ++rep) { DEFPTRS
        { pg8::Gemm g{OA, Wa_t, M, DM, 1024}; pg8::StaticOrder S; S.init(M, DM, G, bx);
          pg8::EpiRow<pg8::F4a> E{{GA, T1}};
          pg8::gemm_phase<pg8::EpiRow<pg8::F4a>, pg8::StaticOrder, true, true>(ldsl, g, S, E, wave); }
        __syncthreads();
        { pg8::Gemm g{OB, Wb_t, M, DM, 1024}; pg8::StaticOrder S; S.init(M, DM, G, bx);
          pg8::EpiRow<pg8::F4b> E{{GB, T1, MG}};
          pg8::gemm_phase<pg8::EpiRow<pg8::F4b>, pg8::StaticOrder, true, true>(ldsl, g, S, E, wave); }
    }
    GRID_BAR();
    { DEFPTRS
        pg8::Gemm g{MG, Wout_t, M, DM, DM}; pg8::StaticOrder S; S.init(M, DM, G, bx);
        pg8::EpiRow<pg8::FRes<true>> E{{x, out, X1B, ssq_x1}};
        pg8::gemm_phase<pg8::EpiRow<pg8::FRes<true>>, pg8::StaticOrder, true, true>(ldsl, g, S, E, wave);
    }
    GRID_BAR();
    for (int rep = 0; rep < REP_P7; ++rep) { DEFPTRS
        pg8::Gemm g{X1B, W1_t, M, DFF, DM}; pg8::StaticOrder S; S.init(M, DFF, G, bx);
        pg8::EpiRow<pg8::F7> E{{Ub, ssq_x1}};
        pg8::gemm_phase<pg8::EpiRow<pg8::F7>, pg8::StaticOrder, true, true>(ldsl, g, S, E, wave);
    }
    GRID_BAR();
    { DEFPTRS
        pg8::Gemm g{Ub, W2_t, M, DM, DFF}; pg8::StaticOrder S; S.init(M, DM, G, bx);
        pg8::EpiRow<pg8::FRes<false>> E{{out, out, nullptr, ssq_x2}};
        pg8::gemm_phase<pg8::EpiRow<pg8::FRes<false>>, pg8::StaticOrder, true, true>(ldsl, g, S, E, wave);
    }
    GRID_BAR();
    DEFPTRS
    const int lane9 = lane_now();
    for (int m = gw; m < M; m += NGW) {
        GAS f32x4* xr = (GAS f32x4*)(out + (size_t)m * DM) + lane9;
        const float rstd = 1.0f / sqrtf(ssq_x2[m] * (1.0f / DM) + 1e-6f);
#pragma unroll
        for (int j = 0; j < 8; ++j) { const f32x4 gg = *((const GAS f32x4*)g_fin + lane9 + 64 * j); const f32x4 xv = __builtin_nontemporal_load(xr + 64 * j); __builtin_nontemporal_store(xv * rstd * gg, xr + 64 * j); }
    }
}

extern "C" void kernel_launch(void* const* d_in, const int* in_sizes, int n_in, void* d_out, int out_size, void* d_ws, size_t ws_size, hipStream_t stream) {
    static int grid = 0;
    if (grid == 0) {
        if (n_in != 17 || in_sizes[0] != M * DM || out_size != M * DM || ws_size < WS_END) { fprintf(stderr, "kernel_launch: unexpected shapes (n_in %d, in0 %d, out %d, ws %zu)\n", n_in, n_in > 0 ? in_sizes[0] : -1, out_size, ws_size); grid = -1; return; }
        int dev = 0, cus = 0, per_cu = 0;
        if (hipGetDevice(&dev) != hipSuccess || hipDeviceGetAttribute(&cus, hipDeviceAttributeMultiprocessorCount, dev) != hipSuccess) { grid = -1; return; }
        if (hipFuncSetAttribute((const void*)mega_fwd, hipFuncAttributeMaxDynamicSharedMemorySize, LDS_BYTES) != hipSuccess) { fprintf(stderr, "kernel_launch: hipFuncSetAttribute failed\n"); grid = -1; return; }
        if (hipOccupancyMaxActiveBlocksPerMultiprocessor(&per_cu, (const void*)mega_fwd, NWAVES * 64, LDS_BYTES) != hipSuccess || per_cu < 1) { fprintf(stderr, "kernel_launch: occupancy query says %d\n", per_cu); per_cu = 1; }
        (void)hipGetLastError();
        grid = cus * per_cu;
    }
    if (grid < 0) return;
    if (hipMemsetAsync((char*)d_ws + WS_CTL, 0, 16384, stream) != hipSuccess) { fprintf(stderr, "kernel_launch: memset failed\n"); return; }
    Args a{};
    for (int i = 0; i < 17; ++i) a.in[i] = d_in[i];
    a.out = (float*)d_out; a.ws = (unsigned char*)d_ws;
    void* kargs[] = {&a};
    const hipError_t e = hipLaunchCooperativeKernel((const void*)mega_fwd, dim3(grid), dim3(NWAVES * 64), kargs, LDS_BYTES, stream);
    if (e != hipSuccess) fprintf(stderr, "kernel_launch: cooperative launch failed: %s (grid %d)\n", hipGetErrorString(e), grid);
}
```
